# Optimizing an MI355X kernel written in HIP

```python
import math
import jax, jax.numpy as jnp
from jax import lax
import numpy as np

D_MODEL = 2048
BATCH = 16
SEQ = 2048
DEPTH = 2
DEC_BATCH = 16
DEC_SEQ = 16
PAST_LEN = 1024

CHUNK = 64
Q_BLOCK = 128
N_LAYERS_A = (DEPTH + 1) // 2
N_LAYERS_B = DEPTH // 2

A_HEAD_DIM = 64
A_HEADS = D_MODEL // (2 * A_HEAD_DIM)
A_QK = 2 * A_HEADS * A_HEAD_DIM
A_V = A_HEADS * 2 * A_HEAD_DIM
A_IN = 2 * A_QK + 2 * A_V
A_ROT_DIM = A_HEAD_DIM // 4
ROPE_THETA = 500000.0

B_HEADS = 8
B_QK = D_MODEL
B_V = 2 * D_MODEL
B_DK = B_QK // B_HEADS
B_DV = B_V // B_HEADS
B_IN = 2 * B_QK + 2 * B_V
XPOS_BASE = 10000.0

NORM_EPS = 1e-6
SUBLN_EPS = 1e-5

kernel_name = 'chunk_causal_diffattn_retention_hybrid_step'


def rmsnorm(x, g, eps):
    xf = x.astype(jnp.float32)
    y = xf * lax.rsqrt(jnp.mean(xf * xf, axis=-1, keepdims=True) + eps)
    return (y * g.astype(jnp.float32)).astype(x.dtype)


def head_rmsnorm(x, eps):
    xf = x.astype(jnp.float32)
    y = xf * lax.rsqrt(jnp.mean(xf * xf, axis=-1, keepdims=True) + eps)
    return y.astype(x.dtype)


def rotate(x, angles):
    half = angles.shape[-1]
    cos = jnp.cos(angles)[None, :, None, :].astype(x.dtype)
    sin = jnp.sin(angles)[None, :, None, :].astype(x.dtype)
    x1 = x[..., :half]
    x2 = x[..., half:2 * half]
    rest = x[..., 2 * half:]
    return jnp.concatenate([x1 * cos - x2 * sin, x1 * sin + x2 * cos, rest], axis=-1)


def partial_rope_angles(pos):
    inv = ROPE_THETA ** (-jnp.arange(0, A_ROT_DIM, 2, dtype=jnp.float32) / A_ROT_DIM)
    return pos[:, None] * inv[None, :]


def xpos_angles(pos):
    inv = 1.0 / (XPOS_BASE ** jnp.linspace(0.0, 1.0, B_DK // 2, dtype=jnp.float32))
    return pos[:, None] * inv[None, :]


def diff_attend(q, k, v, lam, mask):
    b, lq = q.shape[0], q.shape[1]
    lk = k.shape[1]
    s = jnp.einsum('bqhd,bkhd->bhqk', q, k).astype(jnp.float32)
    if mask is not None:
        s = jnp.where(mask, s, -jnp.inf)
    p = jax.nn.softmax(s, axis=-1).reshape(b, A_HEADS, 2, lq, lk)
    a = p[:, :, 0] - lam * p[:, :, 1]
    return jnp.einsum('bhqk,bkhe->bqhe', a.astype(v.dtype), v)


def diff_layer(xp, xs, ck, cv, norm_g, w_in, lq1, lk1, lq2, lk2, subln_g, w_out, layer_idx):
    lambda_init = 0.8 - 0.6 * math.exp(-0.3 * layer_idx)
    lam = (jnp.exp(jnp.sum(lq1 * lk1).astype(jnp.float32))
           - jnp.exp(jnp.sum(lq2 * lk2).astype(jnp.float32)) + lambda_init)
    scale = A_HEAD_DIM ** -0.5

    def project(x, pos):
        b, l = x.shape[0], x.shape[1]
        z = rmsnorm(x, norm_g, NORM_EPS) @ w_in
        q = z[..., :A_QK].reshape(b, l, 2 * A_HEADS, A_HEAD_DIM)
        k = z[..., A_QK:2 * A_QK].reshape(b, l, 2 * A_HEADS, A_HEAD_DIM)
        v = z[..., 2 * A_QK:2 * A_QK + A_V].reshape(b, l, A_HEADS, 2 * A_HEAD_DIM)
        g = z[..., 2 * A_QK + A_V:]
        ang = partial_rope_angles(pos)
        return rotate(q, ang) * scale, rotate(k, ang), v, g

    def finish(x, o, g):
        b, l = x.shape[0], x.shape[1]
        o = rmsnorm(o, subln_g, SUBLN_EPS) * (1.0 - lambda_init)
        return x + (o.reshape(b, l, A_V) * jax.nn.silu(g)) @ w_out

    s_len = xp.shape[1]
    qp, kp, vp, gp = project(xp, jnp.arange(s_len, dtype=jnp.float32))
    outs = []
    for blk in range(s_len // Q_BLOCK):
        q0 = blk * Q_BLOCK
        kend = q0 + Q_BLOCK
        q_chunk = (q0 + jnp.arange(Q_BLOCK)) // CHUNK
        k_chunk = jnp.arange(kend) // CHUNK
        mask = (k_chunk[None, :] <= q_chunk[:, None])[None, None]
        outs.append(diff_attend(qp[:, q0:kend], kp[:, :kend], vp[:, :kend], lam, mask))
    yp = finish(xp, jnp.concatenate(outs, axis=1), gp)

    past = ck.shape[1]
    qs, ks, vs, gs = project(xs, past + jnp.arange(xs.shape[1], dtype=jnp.float32))
    k_all = jnp.concatenate([ck, ks], axis=1)
    v_all = jnp.concatenate([cv, vs], axis=1)
    ys = finish(xs, diff_attend(qs, k_all, v_all, lam, None), gs)
    return yp, ys, kp, vp, ks, vs


def retention_chunk(s_state, q, k, v, log_gamma):
    l = q.shape[1]
    idx = jnp.arange(l, dtype=jnp.float32)
    lg = log_gamma[:, None]
    intra = jnp.exp(lg[:, :, None] * jnp.abs(idx[:, None] - idx[None, :])).astype(q.dtype)
    scores = jnp.einsum('bqhd,bkhd->bhqk', q, k) * intra[None]
    y = jnp.einsum('bhqk,bkhe->bqhe', scores, v)
    q_decay = jnp.exp(lg * (idx + 1.0)).T.astype(q.dtype)
    y = y + jnp.einsum('bqhd,bhde->bqhe', q * q_decay[None, :, :, None], s_state)
    k_decay = jnp.exp(lg * (l - 1.0 - idx)).T.astype(q.dtype)
    chunk_decay = jnp.exp(log_gamma * l).astype(q.dtype)[None, :, None, None]
    s_new = chunk_decay * s_state + jnp.einsum('bkhd,bkhe->bhde', k * k_decay[None, :, :, None], v)
    return s_new, y


def retention_layer(xp, xs, st, norm_g, w_in, w_out):
    log_gamma = jnp.log1p(-jnp.exp2(-5.0 - jnp.arange(B_HEADS, dtype=jnp.float32)))

    def project(x, pos):
        b, l = x.shape[0], x.shape[1]
        z = rmsnorm(x, norm_g, NORM_EPS) @ w_in
        q = z[..., :B_QK].reshape(b, l, B_HEADS, B_DK)
        k = z[..., B_QK:2 * B_QK].reshape(b, l, B_HEADS, B_DK)
        v = z[..., 2 * B_QK:2 * B_QK + B_V].reshape(b, l, B_HEADS, B_DV)
        g = z[..., 2 * B_QK + B_V:]
        ang = xpos_angles(pos)
        return rotate(q, ang), rotate(k, ang) * (B_DK ** -0.5), v, g

    def finish(x, o, g):
        b, l = x.shape[0], x.shape[1]
        o = head_rmsnorm(o, NORM_EPS).reshape(b, l, B_V)
        return x + (o * jax.nn.silu(g)) @ w_out

    b, s_len = xp.shape[0], xp.shape[1]
    n_chunks = s_len // CHUNK
    qp, kp, vp, gp = project(xp, jnp.arange(s_len, dtype=jnp.float32))
    to_chunks = lambda a: a.reshape(b, n_chunks, CHUNK, *a.shape[2:]).swapaxes(0, 1)
    s0 = jnp.zeros((b, B_HEADS, B_DK, B_DV), qp.dtype)
    s_final, yc = lax.scan(lambda s, xs_: retention_chunk(s, xs_[0], xs_[1], xs_[2], log_gamma),
                           s0, (to_chunks(qp), to_chunks(kp), to_chunks(vp)))
    op = yc.swapaxes(0, 1).reshape(b, s_len, B_HEADS, B_DV)
    yp = finish(xp, op, gp)

    qs, ks, vs, gs = project(xs, PAST_LEN + jnp.arange(xs.shape[1], dtype=jnp.float32))
    s_new, os_ = retention_chunk(st.astype(qs.dtype), qs, ks, vs, log_gamma)
    ys = finish(xs, os_, gs)
    return yp, ys, s_final, s_new


def setup_inputs(seed: int = 0) -> dict:
    key = jax.random.key(seed)
    ks = jax.random.split(key, 20)
    nrm = jax.random.normal
    f32 = jnp.float32
    return {
        'x_prompt': nrm(ks[0], (BATCH, SEQ, D_MODEL), f32),
        'x_sample': nrm(ks[1], (DEC_BATCH, DEC_SEQ, D_MODEL), f32),
        'cache_k_a': nrm(ks[2], (N_LAYERS_A, DEC_BATCH, PAST_LEN, 2 * A_HEADS, A_HEAD_DIM), f32),
        'cache_v_a': nrm(ks[3], (N_LAYERS_A, DEC_BATCH, PAST_LEN, A_HEADS, 2 * A_HEAD_DIM), f32),
        'state_ret': 0.5 * nrm(ks[4], (N_LAYERS_B, DEC_BATCH, B_HEADS, B_DK, B_DV), f32),
        'norm_a': 1.0 + 0.02 * nrm(ks[5], (N_LAYERS_A, D_MODEL), f32),
        'w_in_a': nrm(ks[6], (N_LAYERS_A, D_MODEL, A_IN), f32) * D_MODEL ** -0.5,
        'lambda_q1': 0.1 * nrm(ks[7], (N_LAYERS_A, A_HEAD_DIM), f32),
        'lambda_k1': 0.1 * nrm(ks[8], (N_LAYERS_A, A_HEAD_DIM), f32),
        'lambda_q2': 0.1 * nrm(ks[9], (N_LAYERS_A, A_HEAD_DIM), f32),
        'lambda_k2': 0.1 * nrm(ks[10], (N_LAYERS_A, A_HEAD_DIM), f32),
        'subln_a': 1.0 + 0.02 * nrm(ks[11], (N_LAYERS_A, 2 * A_HEAD_DIM), f32),
        'w_out_a': nrm(ks[12], (N_LAYERS_A, A_V, D_MODEL), f32) * A_V ** -0.5,
        'norm_b': 1.0 + 0.02 * nrm(ks[13], (N_LAYERS_B, D_MODEL), f32),
        'w_in_b': nrm(ks[14], (N_LAYERS_B, D_MODEL, B_IN), f32) * D_MODEL ** -0.5,
        'w_out_b': nrm(ks[15], (N_LAYERS_B, B_V, D_MODEL), f32) * B_V ** -0.5,
        'norm_final': 1.0 + 0.02 * nrm(ks[16], (D_MODEL,), f32),
    }


def reference(x_prompt, x_sample, cache_k_a, cache_v_a, state_ret, norm_a, w_in_a,
              lambda_q1, lambda_k1, lambda_q2, lambda_k2, subln_a, w_out_a,
              norm_b, w_in_b, w_out_b, norm_final):
    xp, xs = x_prompt, x_sample
    k_p, v_p, k_s, v_s, sr_p, sr_s = [], [], [], [], [], []
    for i in range(DEPTH):
        j = i // 2
        if i % 2 == 0:
            xp, xs, kp, vp, ks_, vs_ = diff_layer(
                xp, xs, cache_k_a[j], cache_v_a[j], norm_a[j], w_in_a[j],
                lambda_q1[j], lambda_k1[j], lambda_q2[j], lambda_k2[j], subln_a[j], w_out_a[j], i)
            k_p.append(kp)
            v_p.append(vp)
            k_s.append(ks_)
            v_s.append(vs_)
        else:
            xp, xs, sp, ss = retention_layer(xp, xs, state_ret[j], norm_b[j], w_in_b[j], w_out_b[j])
            sr_p.append(sp)
            sr_s.append(ss)
    y_prompt = rmsnorm(xp, norm_final, NORM_EPS)
    y_sample = rmsnorm(xs, norm_final, NORM_EPS)
    new_k_a_prompt = jnp.stack(k_p)
    new_v_a_prompt = jnp.stack(v_p)
    new_state_ret_prompt = jnp.stack(sr_p)
    new_k_a_sample = jnp.stack(k_s)
    new_v_a_sample = jnp.stack(v_s)
    new_state_ret_sample = jnp.stack(sr_s)
    return (y_prompt, y_sample, new_k_a_prompt, new_v_a_prompt, new_state_ret_prompt,
            new_k_a_sample, new_v_a_sample, new_state_ret_sample)
```

```cpp
#include <hip/hip_runtime.h>
#include <cstdio>
#include <cstdint>

constexpr int DM = 2048, SEQ = 2048, NB = 16, DSEQ = 16, PAST = 1024;
constexpr int MP = NB * SEQ;
constexpr int MS = NB * DSEQ;
constexpr int MT = MP + MS;
constexpr int NA_IN = 8192, NB_IN = 12288, BV = 4096;
constexpr float QSCALE = 0.125f * 1.4426950408889634f;
constexpr float LAMBDA_INIT = 0.2f;
constexpr float NORM_EPS = 1e-6f, SUBLN_EPS = 1e-5f;

constexpr size_t OUT_Y_P = 0, OUT_Y_S = OUT_Y_P + (size_t)MP * DM, OUT_K_P = OUT_Y_S + (size_t)MS * DM, OUT_V_P = OUT_K_P + (size_t)MP * DM,
                 OUT_ST_P = OUT_V_P + (size_t)MP * DM, OUT_K_S = OUT_ST_P + (size_t)NB * 8 * 256 * 512, OUT_V_S = OUT_K_S + (size_t)MS * DM,
                 OUT_ST_S = OUT_V_S + (size_t)MS * DM, OUT_TOTAL = OUT_ST_S + (size_t)NB * 8 * 256 * 512;

constexpr size_t MiB = 1u << 20;
constexpr size_t WS_CTL = 0, CTL_ZERO_BYTES = 7 * MiB;
constexpr size_t WS_SSQ1 = 256 * 1024;
constexpr size_t WS_SSQR = 4 * MiB;
constexpr size_t WS_ROPE = 1 * MiB;
constexpr size_t WS_XPOS = 2 * MiB;
constexpr size_t WS_LAM = 7 * MiB;
constexpr size_t WS_WINA = 8 * MiB, WS_WOUTA = 40 * MiB, WS_WINB = 48 * MiB, WS_WOUTB = 96 * MiB;
constexpr size_t ACT = (size_t)MT * DM * 2;
constexpr size_t WS_XN0 = 112 * MiB;
constexpr size_t WS_Q0 = WS_XN0 + ACT;
constexpr size_t WS_K0 = WS_Q0 + ACT;
constexpr size_t WS_V0 = WS_K0 + ACT;
constexpr size_t WS_G0 = WS_V0 + ACT;
constexpr size_t WS_GR = WS_G0 + ACT;
constexpr size_t WS_END = WS_GR + 2 * ACT;
static_assert(WS_END == 1015 * MiB, "ws map");
constexpr int CW_BAR = 4096;

typedef unsigned short bf16_t;
typedef short bf16x8 __attribute__((ext_vector_type(8)));
typedef float f32x4 __attribute__((ext_vector_type(4)));
typedef float f32x16 __attribute__((ext_vector_type(16)));
typedef unsigned u32x4 __attribute__((ext_vector_type(4)));
typedef unsigned u32x2 __attribute__((ext_vector_type(2)));

__device__ __forceinline__ unsigned f2bf(float f) { unsigned u = __builtin_bit_cast(unsigned, f); return (u + 0x7fffu + ((u >> 16) & 1u)) >> 16; }
__device__ __forceinline__ float bf2f(unsigned short b) { return __builtin_bit_cast(float, (unsigned)b << 16); }
__device__ __forceinline__ unsigned pk2(float lo, float hi) { return f2bf(lo) | (f2bf(hi) << 16); }
__device__ __forceinline__ float silu_f(float x) { return x * __builtin_amdgcn_rcpf(1.0f + __builtin_amdgcn_exp2f(-1.4426950408889634f * x)); }
__device__ __forceinline__ float wave_sum(float v) {
#pragma unroll
    for (int o = 1; o < 64; o <<= 1) v += __shfl_xor(v, o);
    return v;
}
__device__ __forceinline__ int row_pos(int row) { return row < MP ? (row & (SEQ - 1)) : PAST + ((row - MP) & (DSEQ - 1)); }

struct Ptrs {
    const float *x_p, *x_s, *ck, *cv, *st, *norm_a, *w_in_a, *lq1, *lk1, *lq2, *lk2, *subln, *w_out_a, *norm_b, *w_in_b, *w_out_b, *norm_f;
    float* out; unsigned char* ws;
};
#define LAS __attribute__((address_space(3)))
#define GAS __attribute__((address_space(1)))
__device__ __forceinline__ void p0_transpose_item(const float* W, const float* gain, int K, int N, bf16_t* WT, LAS float* scr, int item, int lane) {
    const int nblk = N / 32, kb = item / nblk, nb = item % nblk, k0 = 64 * kb, n0 = 32 * nb;
#pragma unroll 8
    for (int i = 0; i < 32; ++i) { const int kk = 2 * i + (lane >> 5); float w = W[(size_t)(k0 + kk) * N + n0 + (lane & 31)]; if (gain) w *= gain[k0 + kk]; scr[kk * 33 + (lane & 31)] = w; }
    asm volatile("s_waitcnt lgkmcnt(0)" ::: "memory");
    const int c = lane & 7;
#pragma unroll
    for (int j = 0; j < 4; ++j) { const int n = (lane >> 3) + 8 * j; const LAS float* s = scr + (8 * c) * 33 + n;
        u32x4 o; o.x = pk2(s[0 * 33], s[1 * 33]); o.y = pk2(s[2 * 33], s[3 * 33]); o.z = pk2(s[4 * 33], s[5 * 33]); o.w = pk2(s[6 * 33], s[7 * 33]);
        *(u32x4*)(WT + (size_t)(n0 + n) * K + k0 + 8 * c) = o; }
    asm volatile("s_waitcnt lgkmcnt(0)" ::: "memory");
}
__device__ __forceinline__ void p0_norm_row(const float* xrow, const float* g, bf16_t* orow, int lane) {
    const f32x4* xr = (const f32x4*)xrow + lane; const f32x4* gr = (const f32x4*)g + lane;
    f32x4 v[8]; float s = 0.f;
#pragma unroll
    for (int j = 0; j < 8; ++j) { v[j] = xr[64 * j]; s += (v[j].x * v[j].x + v[j].y * v[j].y) + (v[j].z * v[j].z + v[j].w * v[j].w); }
    const float r = 1.0f / sqrtf(wave_sum(s) * (1.f / DM) + NORM_EPS);
    u32x2* o8 = (u32x2*)orow + lane;
#pragma unroll
    for (int j = 0; j < 8; ++j) { const f32x4 gg = gr[64 * j]; u32x2 w; w.x = pk2(v[j].x * r * gg.x, v[j].y * r * gg.y); w.y = pk2(v[j].z * r * gg.z, v[j].w * r * gg.w); o8[64 * j] = w; }
}
__device__ __forceinline__ void sincos_rev(float angle, float& c, float& s) {
    const double rev = (double)angle * 0.15915494309189533577; const float fr = (float)(rev - __builtin_rint(rev));
    c = __builtin_amdgcn_cosf(fr); s = __builtin_amdgcn_sinf(fr);
}
__device__ __forceinline__ void p0_prologue(const Ptrs& P, LAS float* scr, int gw, int ngw, int lane) {
    unsigned char* ws = P.ws;
    constexpr int I_INA = (DM / 64) * (NA_IN / 32), I_OUTA = (DM / 64) * (DM / 32), I_INB = (DM / 64) * (NB_IN / 32), I_OUTB = (BV / 64) * (DM / 32);
    constexpr int NITEMS = I_INA + I_OUTA + I_INB + I_OUTB;
    for (int it = gw; it < NITEMS; it += ngw) {
        int r = it;
        if (r < I_INA) { p0_transpose_item(P.w_in_a, nullptr, DM, NA_IN, (bf16_t*)(ws + WS_WINA), scr, r, lane); continue; } r -= I_INA;
        if (r < I_OUTA) { p0_transpose_item(P.w_out_a, nullptr, DM, DM, (bf16_t*)(ws + WS_WOUTA), scr, r, lane); continue; } r -= I_OUTA;
        if (r < I_INB) { p0_transpose_item(P.w_in_b, P.norm_b, DM, NB_IN, (bf16_t*)(ws + WS_WINB), scr, r, lane); continue; } r -= I_INB;
        p0_transpose_item(P.w_out_b, nullptr, BV, DM, (bf16_t*)(ws + WS_WOUTB), scr, r, lane);
    }
    bf16_t* XN = (bf16_t*)(ws + WS_XN0);
    for (int m = gw; m < MT; m += ngw) p0_norm_row(m < MP ? P.x_p + (size_t)m * DM : P.x_s + (size_t)(m - MP) * DM, P.norm_a, XN + (size_t)m * DM, lane);
    float* rc = (float*)(ws + WS_ROPE); float* rs = rc + 2048 * 8;
    for (int i = gw * 64 + lane; i < 2048 * 8; i += ngw * 64) { const int pos = i >> 3, k = i & 7;
        const float inv = (float)exp2(-18.931568569324174 * (double)k / 8.0);
        float c, s; sincos_rev((float)pos * inv, c, s); rc[i] = c; rs[i] = s; }
    float* xc = (float*)(ws + WS_XPOS); float* xs = xc + 2048 * 128;
    for (int i = gw * 64 + lane; i < 2048 * 128; i += ngw * 64) { const int pos = i >> 7, k = i & 127;
        const float e = (float)k * (1.0f / 127.0f);
        const float inv = 1.0f / (float)exp2(13.287712379549449 * (double)e);
        float c, s; sincos_rev((float)pos * inv, c, s); xc[i] = c; xs[i] = s; }
    if (gw == 0) { float a = P.lq1[lane] * P.lk1[lane], b = P.lq2[lane] * P.lk2[lane]; a = wave_sum(a); b = wave_sum(b);
        if (lane == 0) *(float*)(ws + WS_LAM) = expf(a) - expf(b) + LAMBDA_INIT; }
}
namespace orc {
template <class E>
__global__ __launch_bounds__(256) void s_gemm(const bf16_t* __restrict__ A, const bf16_t* __restrict__ Bt, int K, E e) {
    const int wave = threadIdx.x >> 6, lane = threadIdx.x & 63, l15 = lane & 15, kq = lane >> 4;
    const int row0 = blockIdx.y * 64 + (wave >> 1) * 32, col0 = blockIdx.x * 64 + (wave & 1) * 32;
    f32x4 acc[2][2];
#pragma unroll
    for (int i = 0; i < 2; ++i)
#pragma unroll
        for (int j = 0; j < 2; ++j) acc[i][j] = (f32x4){0.f, 0.f, 0.f, 0.f};
    const bf16_t* ap = A + (size_t)(row0 + l15) * K + kq * 8; const bf16_t* bp = Bt + (size_t)(col0 + l15) * K + kq * 8;
    for (int k = 0; k < K; k += 32) {
        bf16x8 a[2], b[2];
#pragma unroll
        for (int i = 0; i < 2; ++i) { a[i] = *(const bf16x8*)(ap + (size_t)i * 16 * K + k); b[i] = *(const bf16x8*)(bp + (size_t)i * 16 * K + k); }
#pragma unroll
        for (int i = 0; i < 2; ++i)
#pragma unroll
            for (int j = 0; j < 2; ++j) acc[i][j] = __builtin_amdgcn_mfma_f32_16x16x32_bf16(a[i], b[j], acc[i][j], 0, 0, 0);
    }
#pragma unroll
    for (int i = 0; i < 2; ++i)
#pragma unroll
        for (int j = 0; j < 2; ++j)
#pragma unroll
            for (int r = 0; r < 4; ++r) e(row0 + i * 16 + kq * 4 + r, col0 + j * 16 + l15, acc[i][j][r]);
}
struct ERaw { bf16_t* base; int secw, ld; size_t stride; const float* ssq;
    __device__ void operator()(int row, int col, float v) const { const int s = col / secw;
        if (ssq) v *= 1.0f / sqrtf(ssq[row] * (1.f / DM) + NORM_EPS);
        base[(size_t)s * stride + (size_t)row * ld + (col - s * secw)] = (bf16_t)f2bf(v); } };
struct ERaw3 { bf16_t *q, *k, *v, *g; const float* ssq;
    __device__ void operator()(int row, int col, float x) const { x *= 1.0f / sqrtf(ssq[row] * (1.f / DM) + NORM_EPS); const bf16_t o = (bf16_t)f2bf(x);
        if (col < 2048) q[(size_t)row * DM + col] = o; else if (col < 4096) k[(size_t)row * DM + col - 2048] = o;
        else if (col < 8192) v[(size_t)row * BV + col - 4096] = o; else g[(size_t)row * BV + col - 8192] = o; } };
struct ERes1 { const float *xp, *xs; float* out; bf16_t* xb;
    __device__ void operator()(int row, int col, float v) const {
        const float x = row < MP ? xp[(size_t)row * DM + col] : xs[(size_t)(row - MP) * DM + col];
        float* o = row < MP ? out + OUT_Y_P + (size_t)row * DM + col : out + OUT_Y_S + (size_t)(row - MP) * DM + col;
        const float r = x + v; *o = r; xb[(size_t)row * DM + col] = (bf16_t)f2bf(r); } };
struct ERes2 { float* out;
    __device__ void operator()(int row, int col, float v) const {
        float* o = row < MP ? out + OUT_Y_P + (size_t)row * DM + col : out + OUT_Y_S + (size_t)(row - MP) * DM + col; *o += v; } };

__global__ __launch_bounds__(256) void s_post1(Ptrs P) {
    const size_t idx = (size_t)blockIdx.x * 256 + threadIdx.x; if (idx >= (size_t)MT * NA_IN) return;
    const int row = (int)(idx / NA_IN), col = (int)(idx % NA_IN), sec = col >> 11, c = col & 2047, c64 = c & 63;
    bf16_t* buf = (bf16_t*)(P.ws + WS_Q0) + (size_t)sec * (ACT / 2) + (size_t)row * DM;
    const float* rc = (const float*)(P.ws + WS_ROPE); const float* rs = rc + 2048 * 8; const int pos = row_pos(row);
    float* ko = row < MP ? P.out + OUT_K_P + (size_t)row * DM : P.out + OUT_K_S + (size_t)(row - MP) * DM;
    float* vo = row < MP ? P.out + OUT_V_P + (size_t)row * DM : P.out + OUT_V_S + (size_t)(row - MP) * DM;
    if (sec <= 1) {
        if (c64 >= 8 && c64 < 16) return;
        if (c64 < 8) { const float x1 = bf2f(buf[c]), x2 = bf2f(buf[c + 8]), cs = rc[pos * 8 + c64], sn = rs[pos * 8 + c64];
            float o1 = x1 * cs - x2 * sn, o2 = x1 * sn + x2 * cs;
            if (sec == 0) { o1 *= QSCALE; o2 *= QSCALE; } else { ko[c] = o1; ko[c + 8] = o2; }
            buf[c] = (bf16_t)f2bf(o1); buf[c + 8] = (bf16_t)f2bf(o2); }
        else { float x = bf2f(buf[c]); if (sec == 0) { x *= QSCALE; buf[c] = (bf16_t)f2bf(x); } else ko[c] = x; }
    } else if (sec == 2) { vo[c] = bf2f(buf[c]); }
    else { buf[c] = (bf16_t)f2bf(silu_f(bf2f(buf[c]))); }
}
__global__ __launch_bounds__(256) void s_post3(Ptrs P) {
    const size_t idx = (size_t)blockIdx.x * 256 + threadIdx.x; if (idx >= (size_t)MT * NB_IN) return;
    const int row = (int)(idx / NB_IN), col = (int)(idx % NB_IN);
    const float* xc = (const float*)(P.ws + WS_XPOS); const float* xs = xc + 2048 * 128; const int pos = row_pos(row);
    if (col < 4096) { const int sec = col >> 11, c = col & 2047, c256 = c & 255; if (c256 >= 128) return;
        bf16_t* buf = (bf16_t*)(P.ws + (sec == 0 ? WS_XN0 : WS_K0)) + (size_t)row * DM;
        const float x1 = bf2f(buf[c]), x2 = bf2f(buf[c + 128]), cs = xc[pos * 128 + c256], sn = xs[pos * 128 + c256];
        float o1 = x1 * cs - x2 * sn, o2 = x1 * sn + x2 * cs; if (sec == 1) { o1 *= 0.0625f; o2 *= 0.0625f; }
        buf[c] = (bf16_t)f2bf(o1); buf[c + 128] = (bf16_t)f2bf(o2);
    } else if (col >= 8192) { bf16_t* g = (bf16_t*)(P.ws + WS_GR) + (size_t)row * BV + (col - 8192); *g = (bf16_t)f2bf(silu_f(bf2f(*g))); }
}
__device__ __forceinline__ float block_sum128(float v, float* red) {
    v = wave_sum(v); __syncthreads(); if ((threadIdx.x & 63) == 0) red[threadIdx.x >> 6] = v; __syncthreads(); return red[0] + red[1]; }
__device__ __forceinline__ float block_max128(float v, float* red) {
#pragma unroll
    for (int o = 1; o < 64; o <<= 1) v = fmaxf(v, __shfl_xor(v, o));
    __syncthreads(); if ((threadIdx.x & 63) == 0) red[threadIdx.x >> 6] = v; __syncthreads(); return fmaxf(red[0], red[1]); }
__global__ __launch_bounds__(128) void s_attn(Ptrs P, int sample) {
    __shared__ float sc0[2112], sc1[2112], qs[128], red[2];
    const int tid = threadIdx.x, h = blockIdx.y; int row, b, nkeys;
    if (!sample) { row = blockIdx.x; b = row >> 11; nkeys = (((row & 2047) >> 6) + 1) << 6; } else { b = blockIdx.x >> 4; row = MP + blockIdx.x; nkeys = PAST + DSEQ; }
    const bf16_t* Q0 = (const bf16_t*)(P.ws + WS_Q0); const bf16_t* K0 = (const bf16_t*)(P.ws + WS_K0); const bf16_t* V0 = (const bf16_t*)(P.ws + WS_V0); const bf16_t* G0 = (const bf16_t*)(P.ws + WS_G0);
    bf16_t* O0 = (bf16_t*)(P.ws + WS_XN0);
    qs[tid] = bf2f(Q0[(size_t)row * DM + h * 128 + tid]); __syncthreads();
    float m0 = -1e30f, m1 = -1e30f;
#pragma unroll 1
    for (int j = tid; j < nkeys; j += 128) { float s0 = 0.f, s1 = 0.f;
        if (sample && j < PAST) { const float* kr = P.ck + ((size_t)(b * PAST + j)) * DM + h * 128;
#pragma unroll 8
            for (int d = 0; d < 64; ++d) { s0 += qs[d] * kr[d]; s1 += qs[64 + d] * kr[64 + d]; } }
        else { const size_t kr_row = sample ? (size_t)(MP + b * DSEQ + (j - PAST)) : (size_t)((b << 11) + j); const bf16_t* kr = K0 + kr_row * DM + h * 128;
#pragma unroll 8
            for (int d = 0; d < 64; ++d) { s0 += qs[d] * bf2f(kr[d]); s1 += qs[64 + d] * bf2f(kr[64 + d]); } }
        sc0[j] = s0; sc1[j] = s1; m0 = fmaxf(m0, s0); m1 = fmaxf(m1, s1); }
    m0 = block_max128(m0, red); m1 = block_max128(m1, red);
    float l0 = 0.f, l1 = 0.f;
    for (int j = tid; j < nkeys; j += 128) { const float p0 = exp2f(sc0[j] - m0), p1 = exp2f(sc1[j] - m1); sc0[j] = p0; sc1[j] = p1; l0 += p0; l1 += p1; }
    l0 = block_sum128(l0, red); l1 = block_sum128(l1, red);
    const float lam = *(const float*)(P.ws + WS_LAM), i0 = 1.0f / l0, i1 = lam / l1;
    __syncthreads();
    float o = 0.f;
#pragma unroll 4
    for (int j = 0; j < nkeys; ++j) { const float a = sc0[j] * i0 - sc1[j] * i1; float v;
        if (sample && j < PAST) v = P.cv[((size_t)(b * PAST + j)) * DM + h * 128 + tid];
        else { const size_t vr = sample ? (size_t)(MP + b * DSEQ + (j - PAST)) : (size_t)((b << 11) + j); v = bf2f(V0[vr * DM + h * 128 + tid]); }
        o += a * v; }
    const float ssq = block_sum128(o * o, red);
    const float r = 1.0f / sqrtf(ssq * (1.f / 128.f) + SUBLN_EPS);
    const float res = o * r * P.subln[tid] * (1.0f - LAMBDA_INIT) * bf2f(G0[(size_t)row * DM + h * 128 + tid]);
    O0[(size_t)row * DM + h * 128 + tid] = (bf16_t)f2bf(res);
}
__global__ __launch_bounds__(256) void s_rowssq(Ptrs P) {
    const int row = blockIdx.x * 4 + (threadIdx.x >> 6), lane = threadIdx.x & 63; if (row >= MT) return;
    const float* x = row < MP ? P.out + OUT_Y_P + (size_t)row * DM : P.out + OUT_Y_S + (size_t)(row - MP) * DM; float s = 0.f;
    for (int i = lane; i < DM; i += 64) s += x[i] * x[i];
    s = wave_sum(s); if (lane == 0) ((float*)(P.ws + WS_SSQ1))[row] = s;
}
__global__ __launch_bounds__(256) void s_ret(Ptrs P) {
    __shared__ bf16_t qs[64 * 256], ks[64 * 256]; __shared__ float vs[64 * 64], sc[64 * 65], ys[64 * 64];
    const int tid = threadIdx.x, dvc = tid & 63, kq = tid >> 6, sl = blockIdx.x, h = blockIdx.y, unit = blockIdx.z;
    const bool smp = unit >= 16; const int b = unit & 15, nch = smp ? 1 : 32, L = smp ? DSEQ : 64; const size_t row0 = smp ? (size_t)MP + b * DSEQ : (size_t)b * SEQ;
    const bf16_t* Qr = (const bf16_t*)(P.ws + WS_XN0); const bf16_t* Kr = (const bf16_t*)(P.ws + WS_K0); const bf16_t* Vr = (const bf16_t*)(P.ws + WS_V0); bf16_t* Gr = (bf16_t*)(P.ws + WS_GR);
    float* ssqR = (float*)(P.ws + WS_SSQR);
    const float lg = log1pf(-exp2f(-5.0f - (float)h));
    float S[64];
    const size_t st_off = (((size_t)b * 8 + h) * 256) * 512 + sl * 64 + dvc;
#pragma unroll
    for (int i = 0; i < 64; ++i) S[i] = smp ? P.st[st_off + (size_t)(64 * kq + i) * 512] : 0.f;
    for (int c = 0; c < nch; ++c) { const size_t r0 = row0 + (size_t)c * 64;
        for (int i = tid; i < 64 * 256; i += 256) { const int t = i >> 8, d = i & 255; const bool ok = t < L;
            qs[i] = ok ? Qr[(r0 + t) * DM + h * 256 + d] : (bf16_t)0; ks[i] = ok ? Kr[(r0 + t) * DM + h * 256 + d] : (bf16_t)0; }
        for (int i = tid; i < 64 * 64; i += 256) { const int t = i >> 6, d = i & 63; vs[i] = t < L ? bf2f(Vr[(r0 + t) * BV + h * 512 + sl * 64 + d]) : 0.f; ys[i] = 0.f; }
        __syncthreads();
        for (int i = 0; i < 16; ++i) { const int id = tid * 16 + i, tq = id >> 6, tk = id & 63; float s = 0.f;
            for (int d = 0; d < 256; ++d) s += bf2f(qs[tq * 256 + d]) * bf2f(ks[tk * 256 + d]);
            sc[tq * 65 + tk] = s * expf(lg * fabsf((float)(tq - tk))); }
        for (int t = 0; t < 64; ++t) { float p = 0.f;
#pragma unroll
            for (int i = 0; i < 64; ++i) p += bf2f(qs[t * 256 + 64 * kq + i]) * S[i];
            atomicAdd(&ys[t * 64 + dvc], p * expf(lg * (float)(t + 1))); }
        __syncthreads();
        for (int t = kq * 16; t < kq * 16 + 16; ++t) { float y = ys[t * 64 + dvc];
            for (int tk = 0; tk < 64; ++tk) y += sc[t * 65 + tk] * vs[tk * 64 + dvc];
            ys[t * 64 + dvc] = y; }
        const float cd = expf(lg * (float)L);
#pragma unroll
        for (int i = 0; i < 64; ++i) S[i] *= cd;
        for (int t = 0; t < L; ++t) { const float vd = vs[t * 64 + dvc] * expf(lg * (float)(L - 1 - t));
#pragma unroll
            for (int i = 0; i < 64; ++i) S[i] += bf2f(ks[t * 256 + 64 * kq + i]) * vd; }
        for (int t = kq * 16; t < kq * 16 + 16; ++t) { const float y = ys[t * 64 + dvc]; const float q = wave_sum(y * y);
            if (t < L) { bf16_t* g = Gr + (r0 + t) * BV + h * 512 + sl * 64 + dvc; *g = (bf16_t)f2bf(y * bf2f(*g));
                if (dvc == 0) atomicAdd(&ssqR[(r0 + t) * 16 + h * 2 + (sl >> 2)], q); } }
        __syncthreads();
    }
    float* so = P.out + (smp ? OUT_ST_S : OUT_ST_P) + st_off;
#pragma unroll
    for (int i = 0; i < 64; ++i) so[(size_t)(64 * kq + i) * 512] = S[i];
}
__global__ __launch_bounds__(256) void s_norm_o1(Ptrs P) {
    const size_t idx = (size_t)blockIdx.x * 256 + threadIdx.x; if (idx >= (size_t)MT * BV) return;
    const size_t row = idx / BV; const int col = (int)(idx % BV), h = col >> 9; const float* q = (const float*)(P.ws + WS_SSQR) + row * 16 + h * 2;
    bf16_t* g = (bf16_t*)(P.ws + WS_GR) + idx; *g = (bf16_t)f2bf(bf2f(*g) / sqrtf((q[0] + q[1]) * (1.f / 512.f) + NORM_EPS));
}
}
#define XB_TMO      128
#define XB_XCNT(j)  (256  + 64 * (j))
#define XB_XSUB(j)  (1280 + 64 * (j))
#define XB_XGEN(j)  (2304 + 64 * (j))
#define XB_TOP      3328
#define XB_TOPGEN   3392
#define XCD_BAR_WORDS 3456
#define XB_SPIN_CAP (1u << 18)
__device__ __forceinline__ unsigned xb_ld(unsigned* p)              { return __hip_atomic_load(p, __ATOMIC_RELAXED, __HIP_MEMORY_SCOPE_AGENT); }
__device__ __forceinline__ unsigned xb_add(unsigned* p, unsigned v) { return __hip_atomic_fetch_add(p, v, __ATOMIC_RELAXED, __HIP_MEMORY_SCOPE_AGENT); }
__device__ __forceinline__ unsigned xb_xcc_id() { return (unsigned)__builtin_amdgcn_s_getreg((3 << 11) | 20) & 0xFu; }
#define XB_SPIN(cond, bar) do { unsigned _sp = 0; while (cond) { __builtin_amdgcn_s_sleep(1); \
    if ((++_sp & 255u) == 0u) { if (xb_ld(&(bar)[XB_TMO])) break; if (_sp > XB_SPIN_CAP) { atomicAdd(&(bar)[XB_TMO], 1u); break; } } } } while (0)
struct XcdBarrier { unsigned* bar; unsigned x; volatile LAS unsigned* st; };
__device__ __forceinline__ XcdBarrier xcd_barrier_post(unsigned* bar, volatile LAS unsigned* st) {
    XcdBarrier b; b.bar = bar; b.x = xb_xcc_id(); b.st = st;
    if (threadIdx.x == 0) (void)xb_add(&bar[XB_XCNT(b.x)], 1u);
    return b;
}
__device__ __forceinline__ void xcd_barrier_complete(unsigned* bar, unsigned x, unsigned& nloc, unsigned& nx) {
    const unsigned G = gridDim.x * gridDim.y * gridDim.z;
    unsigned sum, cnt, mine, sp = 0u;
    for (;;) {
        sum = 0u; cnt = 0u; mine = 0u;
#pragma unroll
        for (unsigned j = 0; j < 16; ++j) { const unsigned c = xb_ld(&bar[XB_XCNT(j)]); sum += c; cnt += (c > 0u) ? 1u : 0u; mine = (j == x) ? c : mine; }
        if (sum == G) break;
        __builtin_amdgcn_s_sleep(1);
        if ((++sp & 255u) == 0u) { if (xb_ld(&bar[XB_TMO])) break; if (sp > XB_SPIN_CAP) { atomicAdd(&bar[XB_TMO], 1u); break; } }
    }
    nloc = mine > 0u ? mine : 1u; nx = cnt > 0u ? cnt : 1u;
}
__device__ __forceinline__ void xcd_barrier(const XcdBarrier& b) {
    asm volatile("s_waitcnt vmcnt(0)" ::: "memory");
    __syncthreads();
    if (threadIdx.x == 0) {
        unsigned* bar = b.bar;
        __builtin_amdgcn_s_waitcnt(0);
        unsigned nloc = b.st[0], nx = b.st[1];
        if (nloc == 0u) { xcd_barrier_complete(bar, b.x, nloc, nx); b.st[0] = nloc; b.st[1] = nx; }
        const unsigned old = xb_add(&bar[XB_XSUB(b.x)], 1u);
        const unsigned gen = old / nloc;
        if (old + 1u == (gen + 1u) * nloc) {
            __builtin_amdgcn_fence(__ATOMIC_RELEASE, "agent");
            asm volatile("s_waitcnt vmcnt(0)" ::: "memory");
            const unsigned og = xb_add(&bar[XB_TOP], 1u);
            const unsigned tg = og / nx;
            if (og + 1u == (tg + 1u) * nx) xb_add(&bar[XB_TOPGEN], 1u);
            else XB_SPIN(xb_ld(&bar[XB_TOPGEN]) == tg, bar);
            __builtin_amdgcn_fence(__ATOMIC_ACQUIRE, "agent");
            xb_add(&bar[XB_XGEN(b.x)], 1u);
            asm volatile("s_waitcnt vmcnt(0)" ::: "memory");
        } else {
            XB_SPIN(xb_ld(&bar[XB_XGEN(b.x)]) == gen, bar);
            __builtin_amdgcn_fence(__ATOMIC_ACQUIRE, "agent");
            asm volatile("s_waitcnt vmcnt(0)" ::: "memory");
        }
    }
    __syncthreads();
}

constexpr int RING_BYTES = 131072;
constexpr int MISC_OFF = RING_BYTES + 320;
constexpr int LDS_BYTES = 147456;
constexpr int NWAVES = 8;

__device__ __forceinline__ void p7_final(const Ptrs& P, int gw, int ngw, int lane) {
    for (int m = gw; m < MT; m += ngw) {
        float* xrow = m < MP ? P.out + OUT_Y_P + (size_t)m * DM : P.out + OUT_Y_S + (size_t)(m - MP) * DM;
        f32x4* xr = (f32x4*)xrow + lane; const f32x4* gr = (const f32x4*)P.norm_f + lane;
        f32x4 v[8]; float s = 0.f;
#pragma unroll
        for (int j = 0; j < 8; ++j) { v[j] = xr[64 * j]; s += (v[j].x * v[j].x + v[j].y * v[j].y) + (v[j].z * v[j].z + v[j].w * v[j].w); }
        const float r = 1.0f / sqrtf(wave_sum(s) * (1.f / DM) + NORM_EPS);
#pragma unroll
        for (int j = 0; j < 8; ++j) { const f32x4 gg = gr[64 * j]; xr[64 * j] = (f32x4){v[j].x * r * gg.x, v[j].y * r * gg.y, v[j].z * r * gg.z, v[j].w * r * gg.w}; }
    }
}
struct Args { Ptrs P; int ph_lo, ph_hi; };
__global__ void __launch_bounds__(NWAVES * 64, 2) mega(Args args) {
    extern __shared__ __attribute__((aligned(16))) unsigned char lds[];
    const Ptrs& P = args.P;
    const int tid = threadIdx.x, lane = tid & 63, wave = __builtin_amdgcn_readfirstlane(tid >> 6);
    const int G = gridDim.x, bx = blockIdx.x, vcu = (G % 8 == 0) ? (bx % 8) * (G / 8) + bx / 8 : bx;
    LAS unsigned char* L = (LAS unsigned char*)lds;
    volatile LAS unsigned* MISC = (volatile LAS unsigned*)(L + MISC_OFF);
    for (int u = tid; u < (LDS_BYTES - RING_BYTES) / 4; u += NWAVES * 64) ((LAS unsigned*)(L + RING_BYTES))[u] = 0u;
    __syncthreads();
    const int lo = args.ph_lo, hi = args.ph_hi;
    const bool multi = hi - lo > 1;
    XcdBarrier bar; bar.bar = (unsigned*)(P.ws + WS_CTL) + CW_BAR; bar.x = 0; bar.st = nullptr;
    if (multi) bar = xcd_barrier_post((unsigned*)(P.ws + WS_CTL) + CW_BAR, MISC + 8);
#define IN(k) (lo <= (k) && (k) < hi)
#define BOTH(k) (IN(k) && IN((k) + 1))
    const int gw = vcu * NWAVES + wave, ngw = G * NWAVES;
    if (IN(0)) { p0_prologue(P, (LAS float*)(L + wave * 16384), gw, ngw, lane); if (BOTH(0)) xcd_barrier(bar); }
    if (IN(7)) { p7_final(P, gw, ngw, lane); }
#undef IN
#undef BOTH
}
extern "C" void kernel_launch(void* const* d_in, const int* in_sizes, int n_in, void* d_out, int out_size, void* d_ws, size_t ws_size, hipStream_t stream) {
    static int grid = 0;
    if (grid == 0) {
        if (n_in != 17 || (size_t)out_size != OUT_TOTAL || ws_size < WS_END) { fprintf(stderr, "kernel_launch: unexpected sizes n_in %d out %d ws %zu (need %zu)\n", n_in, out_size, ws_size, (size_t)WS_END); grid = -1; return; }
        int dev = 0, cus = 0;
        if (hipGetDevice(&dev) != hipSuccess || hipDeviceGetAttribute(&cus, hipDeviceAttributeMultiprocessorCount, dev) != hipSuccess) { grid = -1; return; }
        if (hipFuncSetAttribute((const void*)mega, hipFuncAttributeMaxDynamicSharedMemorySize, LDS_BYTES) != hipSuccess) { fprintf(stderr, "kernel_launch: hipFuncSetAttribute failed\n"); grid = -1; return; }
        int per_cu = 0;
        if (hipOccupancyMaxActiveBlocksPerMultiprocessor(&per_cu, (const void*)mega, NWAVES * 64, LDS_BYTES) != hipSuccess || per_cu < 1) fprintf(stderr, "kernel_launch: occupancy query says %d\n", per_cu);
        (void)hipGetLastError();
        grid = cus;
    }
    if (grid < 0) return;
    Args a{};
    const float** pp = (const float**)&a.P;
    for (int i = 0; i < 17; ++i) pp[i] = (const float*)d_in[i];
    a.P.out = (float*)d_out; a.P.ws = (unsigned char*)d_ws;
    const Ptrs& P = a.P; unsigned char* ws = a.P.ws;
    hipMemsetAsync(ws + WS_CTL, 0, CTL_ZERO_BYTES, stream);
    auto run = [&](int lo, int hi) { a.ph_lo = lo; a.ph_hi = hi; hipLaunchKernelGGL(mega, dim3(grid), dim3(NWAVES * 64), LDS_BYTES, stream, a); };
    bf16_t* XN0 = (bf16_t*)(ws + WS_XN0); bf16_t* Q0 = (bf16_t*)(ws + WS_Q0); bf16_t* K0 = (bf16_t*)(ws + WS_K0); bf16_t* V0 = (bf16_t*)(ws + WS_V0); bf16_t* GR = (bf16_t*)(ws + WS_GR);
    run(0, 1);
    { orc::ERaw e{Q0, 2048, 2048, ACT / 2, nullptr}; hipLaunchKernelGGL(orc::s_gemm<orc::ERaw>, dim3(NA_IN / 64, MT / 64), dim3(256), 0, stream, XN0, (const bf16_t*)(ws + WS_WINA), DM, e); }
    hipLaunchKernelGGL(orc::s_post1, dim3((unsigned)(((size_t)MT * NA_IN + 255) / 256)), dim3(256), 0, stream, P);
    hipLaunchKernelGGL(orc::s_attn, dim3(MP, 16), dim3(128), 0, stream, P, 0);
    hipLaunchKernelGGL(orc::s_attn, dim3(MS, 16), dim3(128), 0, stream, P, 1);
    { orc::ERes1 e{P.x_p, P.x_s, P.out, Q0}; hipLaunchKernelGGL(orc::s_gemm<orc::ERes1>, dim3(DM / 64, MT / 64), dim3(256), 0, stream, XN0, (const bf16_t*)(ws + WS_WOUTA), DM, e); }
    hipLaunchKernelGGL(orc::s_rowssq, dim3(MT / 4), dim3(256), 0, stream, P);
    { orc::ERaw3 e{XN0, K0, V0, GR, (const float*)(ws + WS_SSQ1)}; hipLaunchKernelGGL(orc::s_gemm<orc::ERaw3>, dim3(NB_IN / 64, MT / 64), dim3(256), 0, stream, Q0, (const bf16_t*)(ws + WS_WINB), DM, e); }
    hipLaunchKernelGGL(orc::s_post3, dim3((unsigned)(((size_t)MT * NB_IN + 255) / 256)), dim3(256), 0, stream, P);
    hipLaunchKernelGGL(orc::s_ret, dim3(8, 8, 32), dim3(256), 0, stream, P);
    hipLaunchKernelGGL(orc::s_norm_o1, dim3((unsigned)(((size_t)MT * BV + 255) / 256)), dim3(256), 0, stream, P);
    { orc::ERes2 e{P.out}; hipLaunchKernelGGL(orc::s_gemm<orc::ERes2>, dim3(DM / 64, MT / 64), dim3(256), 0, stream, GR, (const bf16_t*)(ws + WS_WOUTB), BV, e); }
    run(7, 8);
}
```

```cpp
#define FAST_MASK 0x5A
#define PH_MASK 0x5A
#include <hip/hip_runtime.h>
#include <cstdio>
#include <cstdint>

constexpr int DM = 2048, SEQ = 2048, NB = 16, DSEQ = 16, PAST = 1024;
constexpr int MP = NB * SEQ;
constexpr int MS = NB * DSEQ;
constexpr int MT = MP + MS;
constexpr int NA_IN = 8192, NB_IN = 12288, BV = 4096;
constexpr float QSCALE = 0.125f * 1.4426950408889634f;
constexpr float LAMBDA_INIT = 0.2f;
constexpr float NORM_EPS = 1e-6f, SUBLN_EPS = 1e-5f;

constexpr size_t OUT_Y_P = 0, OUT_Y_S = OUT_Y_P + (size_t)MP * DM, OUT_K_P = OUT_Y_S + (size_t)MS * DM, OUT_V_P = OUT_K_P + (size_t)MP * DM,
                 OUT_ST_P = OUT_V_P + (size_t)MP * DM, OUT_K_S = OUT_ST_P + (size_t)NB * 8 * 256 * 512, OUT_V_S = OUT_K_S + (size_t)MS * DM,
                 OUT_ST_S = OUT_V_S + (size_t)MS * DM, OUT_TOTAL = OUT_ST_S + (size_t)NB * 8 * 256 * 512;

constexpr size_t MiB = 1u << 20;
constexpr size_t WS_CTL = 0, CTL_ZERO_BYTES = 7 * MiB;
constexpr size_t WS_SSQ1 = 256 * 1024;
constexpr size_t WS_SSQR = 4 * MiB;
constexpr size_t WS_ROPE = 1 * MiB;
constexpr size_t WS_XPOS = 2 * MiB;
constexpr size_t WS_LAM = 7 * MiB;
constexpr size_t WS_WINA = 8 * MiB, WS_WOUTA = 40 * MiB, WS_WINB = 48 * MiB, WS_WOUTB = 96 * MiB;
constexpr size_t ACT = (size_t)MT * DM * 2;
constexpr size_t WS_XN0 = 112 * MiB;
constexpr size_t WS_Q0 = WS_XN0 + ACT;
constexpr size_t WS_K0 = WS_Q0 + ACT;
constexpr size_t WS_V0 = WS_K0 + ACT;
constexpr size_t WS_G0 = WS_V0 + ACT;
constexpr size_t WS_GR = WS_G0 + ACT;
constexpr size_t WS_END = WS_GR + 2 * ACT;
static_assert(WS_END == 1015 * MiB, "ws map");
constexpr int CW_BAR = 4096;

typedef unsigned short bf16_t;
typedef short bf16x8 __attribute__((ext_vector_type(8)));
typedef float f32x4 __attribute__((ext_vector_type(4)));
typedef float f32x16 __attribute__((ext_vector_type(16)));
typedef unsigned u32x4 __attribute__((ext_vector_type(4)));
typedef unsigned u32x2 __attribute__((ext_vector_type(2)));

__device__ __forceinline__ unsigned f2bf(float f) { unsigned u = __builtin_bit_cast(unsigned, f); return (u + 0x7fffu + ((u >> 16) & 1u)) >> 16; }
__device__ __forceinline__ float bf2f(unsigned short b) { return __builtin_bit_cast(float, (unsigned)b << 16); }
__device__ __forceinline__ unsigned pk2(float lo, float hi) { return f2bf(lo) | (f2bf(hi) << 16); }
__device__ __forceinline__ float silu_f(float x) { return x * __builtin_amdgcn_rcpf(1.0f + __builtin_amdgcn_exp2f(-1.4426950408889634f * x)); }
__device__ __forceinline__ float wave_sum(float v) {
#pragma unroll
    for (int o = 1; o < 64; o <<= 1) v += __shfl_xor(v, o);
    return v;
}
__device__ __forceinline__ int row_pos(int row) { return row < MP ? (row & (SEQ - 1)) : PAST + ((row - MP) & (DSEQ - 1)); }

struct Ptrs {
    const float *x_p, *x_s, *ck, *cv, *st, *norm_a, *w_in_a, *lq1, *lk1, *lq2, *lk2, *subln, *w_out_a, *norm_b, *w_in_b, *w_out_b, *norm_f;
    float* out; unsigned char* ws;
};
#define LAS __attribute__((address_space(3)))
#define GAS __attribute__((address_space(1)))
__device__ __forceinline__ void p0_transpose_item(const float* W, const float* gain, int K, int N, bf16_t* WT, LAS float* scr, int item, int lane) {
    const int nblk = N / 32, kb = item / nblk, nb = item % nblk, k0 = 64 * kb, n0 = 32 * nb;
#pragma unroll 8
    for (int i = 0; i < 32; ++i) { const int kk = 2 * i + (lane >> 5); float w = W[(size_t)(k0 + kk) * N + n0 + (lane & 31)]; if (gain) w *= gain[k0 + kk]; scr[kk * 33 + (lane & 31)] = w; }
    asm volatile("s_waitcnt lgkmcnt(0)" ::: "memory");
    const int c = lane & 7;
#pragma unroll
    for (int j = 0; j < 4; ++j) { const int n = (lane >> 3) + 8 * j; const LAS float* s = scr + (8 * c) * 33 + n;
        u32x4 o; o.x = pk2(s[0 * 33], s[1 * 33]); o.y = pk2(s[2 * 33], s[3 * 33]); o.z = pk2(s[4 * 33], s[5 * 33]); o.w = pk2(s[6 * 33], s[7 * 33]);
        *(u32x4*)(WT + (size_t)(n0 + n) * K + k0 + 8 * c) = o; }
    asm volatile("s_waitcnt lgkmcnt(0)" ::: "memory");
}
__device__ __forceinline__ void p0_norm_row(const float* xrow, const float* g, bf16_t* orow, int lane) {
    const f32x4* xr = (const f32x4*)xrow + lane; const f32x4* gr = (const f32x4*)g + lane;
    f32x4 v[8]; float s = 0.f;
#pragma unroll
    for (int j = 0; j < 8; ++j) { v[j] = xr[64 * j]; s += (v[j].x * v[j].x + v[j].y * v[j].y) + (v[j].z * v[j].z + v[j].w * v[j].w); }
    const float r = 1.0f / sqrtf(wave_sum(s) * (1.f / DM) + NORM_EPS);
    u32x2* o8 = (u32x2*)orow + lane;
#pragma unroll
    for (int j = 0; j < 8; ++j) { const f32x4 gg = gr[64 * j]; u32x2 w; w.x = pk2(v[j].x * r * gg.x, v[j].y * r * gg.y); w.y = pk2(v[j].z * r * gg.z, v[j].w * r * gg.w); o8[64 * j] = w; }
}
__device__ __forceinline__ void sincos_rev(float angle, float& c, float& s) {
    const double rev = (double)angle * 0.15915494309189533577; const float fr = (float)(rev - __builtin_rint(rev));
    c = __builtin_amdgcn_cosf(fr); s = __builtin_amdgcn_sinf(fr);
}
__device__ __forceinline__ void p0_prologue(const Ptrs& P, LAS float* scr, int gw, int ngw, int lane) {
    unsigned char* ws = P.ws;
    constexpr int I_INA = (DM / 64) * (NA_IN / 32), I_OUTA = (DM / 64) * (DM / 32), I_INB = (DM / 64) * (NB_IN / 32), I_OUTB = (BV / 64) * (DM / 32);
    constexpr int NITEMS = I_INA + I_OUTA + I_INB + I_OUTB;
    for (int it = gw; it < NITEMS; it += ngw) {
        int r = it;
        if (r < I_INA) { p0_transpose_item(P.w_in_a, nullptr, DM, NA_IN, (bf16_t*)(ws + WS_WINA), scr, r, lane); continue; } r -= I_INA;
        if (r < I_OUTA) { p0_transpose_item(P.w_out_a, nullptr, DM, DM, (bf16_t*)(ws + WS_WOUTA), scr, r, lane); continue; } r -= I_OUTA;
        if (r < I_INB) { p0_transpose_item(P.w_in_b, P.norm_b, DM, NB_IN, (bf16_t*)(ws + WS_WINB), scr, r, lane); continue; } r -= I_INB;
        p0_transpose_item(P.w_out_b, nullptr, BV, DM, (bf16_t*)(ws + WS_WOUTB), scr, r, lane);
    }
    bf16_t* XN = (bf16_t*)(ws + WS_XN0);
    for (int m = gw; m < MT; m += ngw) p0_norm_row(m < MP ? P.x_p + (size_t)m * DM : P.x_s + (size_t)(m - MP) * DM, P.norm_a, XN + (size_t)m * DM, lane);
    float* rc = (float*)(ws + WS_ROPE); float* rs = rc + 2048 * 8;
    for (int i = gw * 64 + lane; i < 2048 * 8; i += ngw * 64) { const int pos = i >> 3, k = i & 7;
        const float inv = (float)exp2(-18.931568569324174 * (double)k / 8.0);
        float c, s; sincos_rev((float)pos * inv, c, s); rc[i] = c; rs[i] = s; }
    float* xc = (float*)(ws + WS_XPOS); float* xs = xc + 2048 * 128;
    for (int i = gw * 64 + lane; i < 2048 * 128; i += ngw * 64) { const int pos = i >> 7, k = i & 127;
        const float e = (float)k * (1.0f / 127.0f);
        const float inv = 1.0f / (float)exp2(13.287712379549449 * (double)e);
        float c, s; sincos_rev((float)pos * inv, c, s); xc[i] = c; xs[i] = s; }
    if (gw == 0) { float a = P.lq1[lane] * P.lk1[lane], b = P.lq2[lane] * P.lk2[lane]; a = wave_sum(a); b = wave_sum(b);
        if (lane == 0) *(float*)(ws + WS_LAM) = expf(a) - expf(b) + LAMBDA_INIT; }
}
namespace orc {
template <class E>
__global__ __launch_bounds__(256) void s_gemm(const bf16_t* __restrict__ A, const bf16_t* __restrict__ Bt, int K, E e) {
    const int wave = threadIdx.x >> 6, lane = threadIdx.x & 63, l15 = lane & 15, kq = lane >> 4;
    const int row0 = blockIdx.y * 64 + (wave >> 1) * 32, col0 = blockIdx.x * 64 + (wave & 1) * 32;
    f32x4 acc[2][2];
#pragma unroll
    for (int i = 0; i < 2; ++i)
#pragma unroll
        for (int j = 0; j < 2; ++j) acc[i][j] = (f32x4){0.f, 0.f, 0.f, 0.f};
    const bf16_t* ap = A + (size_t)(row0 + l15) * K + kq * 8; const bf16_t* bp = Bt + (size_t)(col0 + l15) * K + kq * 8;
    for (int k = 0; k < K; k += 32) {
        bf16x8 a[2], b[2];
#pragma unroll
        for (int i = 0; i < 2; ++i) { a[i] = *(const bf16x8*)(ap + (size_t)i * 16 * K + k); b[i] = *(const bf16x8*)(bp + (size_t)i * 16 * K + k); }
#pragma unroll
        for (int i = 0; i < 2; ++i)
#pragma unroll
            for (int j = 0; j < 2; ++j) acc[i][j] = __builtin_amdgcn_mfma_f32_16x16x32_bf16(a[i], b[j], acc[i][j], 0, 0, 0);
    }
#pragma unroll
    for (int i = 0; i < 2; ++i)
#pragma unroll
        for (int j = 0; j < 2; ++j)
#pragma unroll
            for (int r = 0; r < 4; ++r) e(row0 + i * 16 + kq * 4 + r, col0 + j * 16 + l15, acc[i][j][r]);
}
struct ERaw { bf16_t* base; int secw, ld; size_t stride; const float* ssq;
    __device__ void operator()(int row, int col, float v) const { const int s = col / secw;
        if (ssq) v *= 1.0f / sqrtf(ssq[row] * (1.f / DM) + NORM_EPS);
        base[(size_t)s * stride + (size_t)row * ld + (col - s * secw)] = (bf16_t)f2bf(v); } };
struct ERaw3 { bf16_t *q, *k, *v, *g; const float* ssq;
    __device__ void operator()(int row, int col, float x) const { x *= 1.0f / sqrtf(ssq[row] * (1.f / DM) + NORM_EPS); const bf16_t o = (bf16_t)f2bf(x);
        if (col < 2048) q[(size_t)row * DM + col] = o; else if (col < 4096) k[(size_t)row * DM + col - 2048] = o;
        else if (col < 8192) v[(size_t)row * BV + col - 4096] = o; else g[(size_t)row * BV + col - 8192] = o; } };
struct ERes1 { const float *xp, *xs; float* out; bf16_t* xb;
    __device__ void operator()(int row, int col, float v) const {
        const float x = row < MP ? xp[(size_t)row * DM + col] : xs[(size_t)(row - MP) * DM + col];
        float* o = row < MP ? out + OUT_Y_P + (size_t)row * DM + col : out + OUT_Y_S + (size_t)(row - MP) * DM + col;
        const float r = x + v; *o = r; xb[(size_t)row * DM + col] = (bf16_t)f2bf(r); } };
struct ERes2 { float* out;
    __device__ void operator()(int row, int col, float v) const {
        float* o = row < MP ? out + OUT_Y_P + (size_t)row * DM + col : out + OUT_Y_S + (size_t)(row - MP) * DM + col; *o += v; } };

__global__ __launch_bounds__(256) void s_post1(Ptrs P) {
    const size_t idx = (size_t)blockIdx.x * 256 + threadIdx.x; if (idx >= (size_t)MT * NA_IN) return;
    const int row = (int)(idx / NA_IN), col = (int)(idx % NA_IN), sec = col >> 11, c = col & 2047, c64 = c & 63;
    bf16_t* buf = (bf16_t*)(P.ws + WS_Q0) + (size_t)sec * (ACT / 2) + (size_t)row * DM;
    const float* rc = (const float*)(P.ws + WS_ROPE); const float* rs = rc + 2048 * 8; const int pos = row_pos(row);
    float* ko = row < MP ? P.out + OUT_K_P + (size_t)row * DM : P.out + OUT_K_S + (size_t)(row - MP) * DM;
    float* vo = row < MP ? P.out + OUT_V_P + (size_t)row * DM : P.out + OUT_V_S + (size_t)(row - MP) * DM;
    if (sec <= 1) {
        if (c64 >= 8 && c64 < 16) return;
        if (c64 < 8) { const float x1 = bf2f(buf[c]), x2 = bf2f(buf[c + 8]), cs = rc[pos * 8 + c64], sn = rs[pos * 8 + c64];
            float o1 = x1 * cs - x2 * sn, o2 = x1 * sn + x2 * cs;
            if (sec == 0) { o1 *= QSCALE; o2 *= QSCALE; } else { ko[c] = o1; ko[c + 8] = o2; }
            buf[c] = (bf16_t)f2bf(o1); buf[c + 8] = (bf16_t)f2bf(o2); }
        else { float x = bf2f(buf[c]); if (sec == 0) { x *= QSCALE; buf[c] = (bf16_t)f2bf(x); } else ko[c] = x; }
    } else if (sec == 2) { vo[c] = bf2f(buf[c]); }
    else { buf[c] = (bf16_t)f2bf(silu_f(bf2f(buf[c]))); }
}
__global__ __launch_bounds__(256) void s_post3(Ptrs P) {
    const size_t idx = (size_t)blockIdx.x * 256 + threadIdx.x; if (idx >= (size_t)MT * NB_IN) return;
    const int row = (int)(idx / NB_IN), col = (int)(idx % NB_IN);
    const float* xc = (const float*)(P.ws + WS_XPOS); const float* xs = xc + 2048 * 128; const int pos = row_pos(row);
    if (col < 4096) { const int sec = col >> 11, c = col & 2047, c256 = c & 255; if (c256 >= 128) return;
        bf16_t* buf = (bf16_t*)(P.ws + (sec == 0 ? WS_XN0 : WS_K0)) + (size_t)row * DM;
        const float x1 = bf2f(buf[c]), x2 = bf2f(buf[c + 128]), cs = xc[pos * 128 + c256], sn = xs[pos * 128 + c256];
        float o1 = x1 * cs - x2 * sn, o2 = x1 * sn + x2 * cs; if (sec == 1) { o1 *= 0.0625f; o2 *= 0.0625f; }
        buf[c] = (bf16_t)f2bf(o1); buf[c + 128] = (bf16_t)f2bf(o2);
    } else if (col >= 8192) { bf16_t* g = (bf16_t*)(P.ws + WS_GR) + (size_t)row * BV + (col - 8192); *g = (bf16_t)f2bf(silu_f(bf2f(*g))); }
}
__device__ __forceinline__ float block_sum128(float v, float* red) {
    v = wave_sum(v); __syncthreads(); if ((threadIdx.x & 63) == 0) red[threadIdx.x >> 6] = v; __syncthreads(); return red[0] + red[1]; }
__device__ __forceinline__ float block_max128(float v, float* red) {
#pragma unroll
    for (int o = 1; o < 64; o <<= 1) v = fmaxf(v, __shfl_xor(v, o));
    __syncthreads(); if ((threadIdx.x & 63) == 0) red[threadIdx.x >> 6] = v; __syncthreads(); return fmaxf(red[0], red[1]); }
__global__ __launch_bounds__(128) void s_attn(Ptrs P, int sample) {
    __shared__ float sc0[2112], sc1[2112], qs[128], red[2];
    const int tid = threadIdx.x, h = blockIdx.y; int row, b, nkeys;
    if (!sample) { row = blockIdx.x; b = row >> 11; nkeys = (((row & 2047) >> 6) + 1) << 6; } else { b = blockIdx.x >> 4; row = MP + blockIdx.x; nkeys = PAST + DSEQ; }
    const bf16_t* Q0 = (const bf16_t*)(P.ws + WS_Q0); const bf16_t* K0 = (const bf16_t*)(P.ws + WS_K0); const bf16_t* V0 = (const bf16_t*)(P.ws + WS_V0); const bf16_t* G0 = (const bf16_t*)(P.ws + WS_G0);
    bf16_t* O0 = (bf16_t*)(P.ws + WS_XN0);
    qs[tid] = bf2f(Q0[(size_t)row * DM + h * 128 + tid]); __syncthreads();
    float m0 = -1e30f, m1 = -1e30f;
#pragma unroll 1
    for (int j = tid; j < nkeys; j += 128) { float s0 = 0.f, s1 = 0.f;
        if (sample && j < PAST) { const float* kr = P.ck + ((size_t)(b * PAST + j)) * DM + h * 128;
#pragma unroll 8
            for (int d = 0; d < 64; ++d) { s0 += qs[d] * kr[d]; s1 += qs[64 + d] * kr[64 + d]; } }
        else { const size_t kr_row = sample ? (size_t)(MP + b * DSEQ + (j - PAST)) : (size_t)((b << 11) + j); const bf16_t* kr = K0 + kr_row * DM + h * 128;
#pragma unroll 8
            for (int d = 0; d < 64; ++d) { s0 += qs[d] * bf2f(kr[d]); s1 += qs[64 + d] * bf2f(kr[64 + d]); } }
        sc0[j] = s0; sc1[j] = s1; m0 = fmaxf(m0, s0); m1 = fmaxf(m1, s1); }
    m0 = block_max128(m0, red); m1 = block_max128(m1, red);
    float l0 = 0.f, l1 = 0.f;
    for (int j = tid; j < nkeys; j += 128) { const float p0 = exp2f(sc0[j] - m0), p1 = exp2f(sc1[j] - m1); sc0[j] = p0; sc1[j] = p1; l0 += p0; l1 += p1; }
    l0 = block_sum128(l0, red); l1 = block_sum128(l1, red);
    const float lam = *(const float*)(P.ws + WS_LAM), i0 = 1.0f / l0, i1 = lam / l1;
    __syncthreads();
    float o = 0.f;
#pragma unroll 4
    for (int j = 0; j < nkeys; ++j) { const float a = sc0[j] * i0 - sc1[j] * i1; float v;
        if (sample && j < PAST) v = P.cv[((size_t)(b * PAST + j)) * DM + h * 128 + tid];
        else { const size_t vr = sample ? (size_t)(MP + b * DSEQ + (j - PAST)) : (size_t)((b << 11) + j); v = bf2f(V0[vr * DM + h * 128 + tid]); }
        o += a * v; }
    const float ssq = block_sum128(o * o, red);
    const float r = 1.0f / sqrtf(ssq * (1.f / 128.f) + SUBLN_EPS);
    const float res = o * r * P.subln[tid] * (1.0f - LAMBDA_INIT) * bf2f(G0[(size_t)row * DM + h * 128 + tid]);
    O0[(size_t)row * DM + h * 128 + tid] = (bf16_t)f2bf(res);
}
__global__ __launch_bounds__(256) void s_rowssq(Ptrs P) {
    const int row = blockIdx.x * 4 + (threadIdx.x >> 6), lane = threadIdx.x & 63; if (row >= MT) return;
    const float* x = row < MP ? P.out + OUT_Y_P + (size_t)row * DM : P.out + OUT_Y_S + (size_t)(row - MP) * DM; float s = 0.f;
    for (int i = lane; i < DM; i += 64) s += x[i] * x[i];
    s = wave_sum(s); if (lane == 0) ((float*)(P.ws + WS_SSQ1))[row] = s;
}
__global__ __launch_bounds__(256) void s_ret(Ptrs P) {
    __shared__ bf16_t qs[64 * 256], ks[64 * 256]; __shared__ float vs[64 * 64], sc[64 * 65], ys[64 * 64];
    const int tid = threadIdx.x, dvc = tid & 63, kq = tid >> 6, sl = blockIdx.x, h = blockIdx.y, unit = blockIdx.z;
    const bool smp = unit >= 16; const int b = unit & 15, nch = smp ? 1 : 32, L = smp ? DSEQ : 64; const size_t row0 = smp ? (size_t)MP + b * DSEQ : (size_t)b * SEQ;
    const bf16_t* Qr = (const bf16_t*)(P.ws + WS_XN0); const bf16_t* Kr = (const bf16_t*)(P.ws + WS_K0); const bf16_t* Vr = (const bf16_t*)(P.ws + WS_V0); bf16_t* Gr = (bf16_t*)(P.ws + WS_GR);
    float* ssqR = (float*)(P.ws + WS_SSQR);
    const float lg = log1pf(-exp2f(-5.0f - (float)h));
    float S[64];
    const size_t st_off = (((size_t)b * 8 + h) * 256) * 512 + sl * 64 + dvc;
#pragma unroll
    for (int i = 0; i < 64; ++i) S[i] = smp ? P.st[st_off + (size_t)(64 * kq + i) * 512] : 0.f;
    for (int c = 0; c < nch; ++c) { const size_t r0 = row0 + (size_t)c * 64;
        for (int i = tid; i < 64 * 256; i += 256) { const int t = i >> 8, d = i & 255; const bool ok = t < L;
            qs[i] = ok ? Qr[(r0 + t) * DM + h * 256 + d] : (bf16_t)0; ks[i] = ok ? Kr[(r0 + t) * DM + h * 256 + d] : (bf16_t)0; }
        for (int i = tid; i < 64 * 64; i += 256) { const int t = i >> 6, d = i & 63; vs[i] = t < L ? bf2f(Vr[(r0 + t) * BV + h * 512 + sl * 64 + d]) : 0.f; ys[i] = 0.f; }
        __syncthreads();
        for (int i = 0; i < 16; ++i) { const int id = tid * 16 + i, tq = id >> 6, tk = id & 63; float s = 0.f;
            for (int d = 0; d < 256; ++d) s += bf2f(qs[tq * 256 + d]) * bf2f(ks[tk * 256 + d]);
            sc[tq * 65 + tk] = s * expf(lg * fabsf((float)(tq - tk))); }
        for (int t = 0; t < 64; ++t) { float p = 0.f;
#pragma unroll
            for (int i = 0; i < 64; ++i) p += bf2f(qs[t * 256 + 64 * kq + i]) * S[i];
            atomicAdd(&ys[t * 64 + dvc], p * expf(lg * (float)(t + 1))); }
        __syncthreads();
        for (int t = kq * 16; t < kq * 16 + 16; ++t) { float y = ys[t * 64 + dvc];
            for (int tk = 0; tk < 64; ++tk) y += sc[t * 65 + tk] * vs[tk * 64 + dvc];
            ys[t * 64 + dvc] = y; }
        const float cd = expf(lg * (float)L);
#pragma unroll
        for (int i = 0; i < 64; ++i) S[i] *= cd;
        for (int t = 0; t < L; ++t) { const float vd = vs[t * 64 + dvc] * expf(lg * (float)(L - 1 - t));
#pragma unroll
            for (int i = 0; i < 64; ++i) S[i] += bf2f(ks[t * 256 + 64 * kq + i]) * vd; }
        for (int t = kq * 16; t < kq * 16 + 16; ++t) { const float y = ys[t * 64 + dvc]; const float q = wave_sum(y * y);
            if (t < L) { bf16_t* g = Gr + (r0 + t) * BV + h * 512 + sl * 64 + dvc; *g = (bf16_t)f2bf(y * bf2f(*g));
                if (dvc == 0) atomicAdd(&ssqR[(r0 + t) * 16 + h * 2 + (sl >> 2)], q); } }
        __syncthreads();
    }
    float* so = P.out + (smp ? OUT_ST_S : OUT_ST_P) + st_off;
#pragma unroll
    for (int i = 0; i < 64; ++i) so[(size_t)(64 * kq + i) * 512] = S[i];
}
__global__ __launch_bounds__(256) void s_norm_o1(Ptrs P) {
    const size_t idx = (size_t)blockIdx.x * 256 + threadIdx.x; if (idx >= (size_t)MT * BV) return;
    const size_t row = idx / BV; const int col = (int)(idx % BV), h = col >> 9; const float* q = (const float*)(P.ws + WS_SSQR) + row * 16 + h * 2;
    bf16_t* g = (bf16_t*)(P.ws + WS_GR) + idx; *g = (bf16_t)f2bf(bf2f(*g) / sqrtf((q[0] + q[1]) * (1.f / 512.f) + NORM_EPS));
}
}
#define XB_TMO      128
#define XB_XCNT(j)  (256  + 64 * (j))
#define XB_XSUB(j)  (1280 + 64 * (j))
#define XB_XGEN(j)  (2304 + 64 * (j))
#define XB_TOP      3328
#define XB_TOPGEN   3392
#define XCD_BAR_WORDS 3456
#define XB_SPIN_CAP (1u << 18)
__device__ __forceinline__ unsigned xb_ld(unsigned* p)              { return __hip_atomic_load(p, __ATOMIC_RELAXED, __HIP_MEMORY_SCOPE_AGENT); }
__device__ __forceinline__ unsigned xb_add(unsigned* p, unsigned v) { return __hip_atomic_fetch_add(p, v, __ATOMIC_RELAXED, __HIP_MEMORY_SCOPE_AGENT); }
__device__ __forceinline__ unsigned xb_xcc_id() { return (unsigned)__builtin_amdgcn_s_getreg((3 << 11) | 20) & 0xFu; }
#define XB_SPIN(cond, bar) do { unsigned _sp = 0; while (cond) { __builtin_amdgcn_s_sleep(1); \
    if ((++_sp & 255u) == 0u) { if (xb_ld(&(bar)[XB_TMO])) break; if (_sp > XB_SPIN_CAP) { atomicAdd(&(bar)[XB_TMO], 1u); break; } } } } while (0)
struct XcdBarrier { unsigned* bar; unsigned x; volatile LAS unsigned* st; };
__device__ __forceinline__ XcdBarrier xcd_barrier_post(unsigned* bar, volatile LAS unsigned* st) {
    XcdBarrier b; b.bar = bar; b.x = xb_xcc_id(); b.st = st;
    if (threadIdx.x == 0) (void)xb_add(&bar[XB_XCNT(b.x)], 1u);
    return b;
}
__device__ __forceinline__ void xcd_barrier_complete(unsigned* bar, unsigned x, unsigned& nloc, unsigned& nx) {
    const unsigned G = gridDim.x * gridDim.y * gridDim.z;
    unsigned sum, cnt, mine, sp = 0u;
    for (;;) {
        sum = 0u; cnt = 0u; mine = 0u;
#pragma unroll
        for (unsigned j = 0; j < 16; ++j) { const unsigned c = xb_ld(&bar[XB_XCNT(j)]); sum += c; cnt += (c > 0u) ? 1u : 0u; mine = (j == x) ? c : mine; }
        if (sum == G) break;
        __builtin_amdgcn_s_sleep(1);
        if ((++sp & 255u) == 0u) { if (xb_ld(&bar[XB_TMO])) break; if (sp > XB_SPIN_CAP) { atomicAdd(&bar[XB_TMO], 1u); break; } }
    }
    nloc = mine > 0u ? mine : 1u; nx = cnt > 0u ? cnt : 1u;
}
__device__ __forceinline__ void xcd_barrier(const XcdBarrier& b) {
    asm volatile("s_waitcnt vmcnt(0)" ::: "memory");
    __syncthreads();
    if (threadIdx.x == 0) {
        unsigned* bar = b.bar;
        __builtin_amdgcn_s_waitcnt(0);
        unsigned nloc = b.st[0], nx = b.st[1];
        if (nloc == 0u) { xcd_barrier_complete(bar, b.x, nloc, nx); b.st[0] = nloc; b.st[1] = nx; }
        const unsigned old = xb_add(&bar[XB_XSUB(b.x)], 1u);
        const unsigned gen = old / nloc;
        if (old + 1u == (gen + 1u) * nloc) {
            __builtin_amdgcn_fence(__ATOMIC_RELEASE, "agent");
            asm volatile("s_waitcnt vmcnt(0)" ::: "memory");
            const unsigned og = xb_add(&bar[XB_TOP], 1u);
            const unsigned tg = og / nx;
            if (og + 1u == (tg + 1u) * nx) xb_add(&bar[XB_TOPGEN], 1u);
            else XB_SPIN(xb_ld(&bar[XB_TOPGEN]) == tg, bar);
            __builtin_amdgcn_fence(__ATOMIC_ACQUIRE, "agent");
            xb_add(&bar[XB_XGEN(b.x)], 1u);
            asm volatile("s_waitcnt vmcnt(0)" ::: "memory");
        } else {
            XB_SPIN(xb_ld(&bar[XB_XGEN(b.x)]) == gen, bar);
            __builtin_amdgcn_fence(__ATOMIC_ACQUIRE, "agent");
            asm volatile("s_waitcnt vmcnt(0)" ::: "memory");
        }
    }
    __syncthreads();
}

constexpr int RING_BYTES = 131072;
constexpr int MISC_OFF = RING_BYTES + 320;
constexpr int LDS_BYTES = 147456;
constexpr int NWAVES = 8;

__device__ __forceinline__ int fresh_lane() { int z; asm volatile("v_mov_b32 %0, 0" : "=v"(z)); return (int)__builtin_amdgcn_mbcnt_hi(~0u, __builtin_amdgcn_mbcnt_lo(~0u, (unsigned)z)); }
__device__ __forceinline__ void p7_final(const Ptrs& P, int gw, int ngw, int lane) {
    for (int m = gw; m < MT; m += ngw) {
        float* xrow = m < MP ? P.out + OUT_Y_P + (size_t)m * DM : P.out + OUT_Y_S + (size_t)(m - MP) * DM;
        f32x4* xr = (f32x4*)xrow + lane; const f32x4* gr = (const f32x4*)P.norm_f + lane;
        f32x4 v[8]; float s = 0.f;
#pragma unroll
        for (int j = 0; j < 8; ++j) { v[j] = xr[64 * j]; s += (v[j].x * v[j].x + v[j].y * v[j].y) + (v[j].z * v[j].z + v[j].w * v[j].w); }
        const float r = 1.0f / sqrtf(wave_sum(s) * (1.f / DM) + NORM_EPS);
#pragma unroll
        for (int j = 0; j < 8; ++j) { const f32x4 gg = gr[64 * j]; xr[64 * j] = (f32x4){v[j].x * r * gg.x, v[j].y * r * gg.y, v[j].z * r * gg.z, v[j].w * r * gg.w}; }
    }
}
namespace pg8 {
#define PG8_LAS __attribute__((address_space(3)))
constexpr int BM = 256, BK = 64, HALF = 128, HTB = HALF * BK * 2  , STAGE_BYTES = 8 * HTB, NXCD = 8, WGM = 8;

__host__ __device__ __forceinline__ int lds_byte(int r, int c) { const int st = (r >> 4) * 2 + (c >> 5), rr = r & 15, cc = c & 31, ob = rr * 64 + cc * 2; return st * 1024 + (ob ^ (((ob >> 9) & 1) << 5)); }
__host__ __device__ __forceinline__ void stage_rc(int b, int& R, int& C) { const int st = b / 1024, sb = b % 1024, swz = sb ^ (((sb >> 9) & 1) << 5); R = (st >> 1) * 16 + swz / 64; C = (st & 1) * 32 + (swz % 64) / 2; }
__host__ __device__ __forceinline__ int perm32(int rho) { const int n = rho >> 4, i = rho & 15; return 8 * (i >> 2) + 4 * n + (i & 3); }

struct Unit { int pm, pn; };
struct Gemm { const bf16_t* A; const bf16_t* Bt; int M, N, K; };

struct StaticOrder {
    int nM, nN, nwg, G, c;
    __host__ __device__ void init(int M, int N, int G_, int c_) { nM = M / BM; nN = N / BM; nwg = nM * nN; G = G_; c = c_; }
    __host__ __device__ bool next(int i, Unit& u) const {
        const long L = (long)i * G + c; if (L >= nwg) return false;
        int wgid = (int)L; { const int q = nwg / NXCD, r = nwg % NXCD, xcd = wgid % NXCD, off = wgid / NXCD; wgid = (xcd < r ? xcd * (q + 1) : r * (q + 1) + (xcd - r) * q) + off; }
        const int nig = WGM * nN, gid = wgid / nig, fm = gid * WGM, gsz = (nM - fm) < WGM ? (nM - fm) : WGM;
        u.pm = fm + ((wgid % nig) % gsz); u.pn = (wgid % nig) / gsz; return true;
    }
    __device__ __forceinline__ void a_ready(const Unit&) const {}
    __device__ __forceinline__ void done(const Unit&) const {}
};

__device__ __forceinline__ unsigned cvt_pk_bf16(float lo, float hi) { unsigned r; asm volatile("v_cvt_pk_bf16_f32 %0, %1, %2" : "=v"(r) : "v"(lo), "v"(hi)); return r; }
typedef float f32x2 __attribute__((ext_vector_type(2)));
__device__ __forceinline__ u32x4 pack8(f32x4 a, f32x4 b) { u32x4 w; w.x = cvt_pk_bf16(a[0], a[1]); w.y = cvt_pk_bf16(a[2], a[3]); w.z = cvt_pk_bf16(b[0], b[1]); w.w = cvt_pk_bf16(b[2], b[3]); return w; }
__device__ __forceinline__ f32x4 shx16(f32x4 v) { f32x4 r; r[0] = __shfl_xor(v[0], 16); r[1] = __shfl_xor(v[1], 16); r[2] = __shfl_xor(v[2], 16); r[3] = __shfl_xor(v[3], 16); return r; }
__device__ __forceinline__ f32x4 silu4(f32x4 v) { return (f32x4){silu_f(v[0]), silu_f(v[1]), silu_f(v[2]), silu_f(v[3])}; }
__device__ __forceinline__ float dot4(f32x4 a) { return (a[0] * a[0] + a[1] * a[1]) + (a[2] * a[2] + a[3] * a[3]); }
struct EpiA1 {
    static constexpr bool PERM = true, AFTER_DRAIN = false, KHOOK = false;
    bf16_t* Q0; float* out; const float* ropeC; const float* ropeS;
    __device__ __forceinline__ void operator()(const f32x4 (&acc)[2][2][4][2], const Unit& u, int wr, int wc, int fr, int fq) const {
        const int sec = u.pn >> 3, col0 = (u.pn & 7) * BM + wc * 32 + 8 * fq;
        bf16_t* base = Q0 + (size_t)sec * (ACT / 2);
        const bool rot = (sec <= 1) && ((wc & 1) == 0);
#pragma unroll
        for (int ai = 0; ai < 2; ++ai)
#pragma unroll
            for (int m = 0; m < 4; ++m) {
                const int row = u.pm * BM + ai * HALF + wr * 64 + m * 16 + fr, pos = row_pos(row);
                f32x4 c0 = {1.f, 1.f, 1.f, 1.f}, c1 = c0, s0 = {0.f, 0.f, 0.f, 0.f}, s1 = s0;
                if (rot && fq < 2) { c0 = *(const f32x4*)(ropeC + pos * 8); c1 = *(const f32x4*)(ropeC + pos * 8 + 4); s0 = *(const f32x4*)(ropeS + pos * 8); s1 = *(const f32x4*)(ropeS + pos * 8 + 4); }
                float* fo = nullptr;
                if (sec == 1) fo = row < MP ? out + OUT_K_P + (size_t)row * DM : out + OUT_K_S + (size_t)(row - MP) * DM;
                else if (sec == 2) fo = row < MP ? out + OUT_V_P + (size_t)row * DM : out + OUT_V_S + (size_t)(row - MP) * DM;
#pragma unroll
                for (int bj = 0; bj < 2; ++bj) { f32x4 v0 = acc[ai][bj][m][0], v1 = acc[ai][bj][m][1]; const int col = col0 + bj * HALF;
                    if (rot) { const f32x4 p0 = shx16(v0), p1 = shx16(v1);
                        if (fq == 0) { v0 = v0 * c0 - p0 * s0; v1 = v1 * c1 - p1 * s1; } else if (fq == 1) { v0 = p0 * s0 + v0 * c0; v1 = p1 * s1 + v1 * c1; } }
                    if (sec == 0) { v0 = v0 * QSCALE; v1 = v1 * QSCALE; } else if (sec == 3) { v0 = silu4(v0); v1 = silu4(v1); }
                    if (fo) { *(f32x4*)(fo + col) = v0; *(f32x4*)(fo + col + 4) = v1; }
                    *(u32x4*)(base + (size_t)row * DM + col) = pack8(v0, v1); }
            }
    }
};
struct EpiA2 {
    static constexpr bool PERM = true, AFTER_DRAIN = false, KHOOK = false;
    const float *xp, *xs; float* out; bf16_t* xb; float* ssq;
    __device__ __forceinline__ void operator()(const f32x4 (&acc)[2][2][4][2], const Unit& u, int wr, int wc, int fr, int fq) const {
        const int col0 = u.pn * BM + wc * 32 + 8 * fq;
#pragma unroll
        for (int ai = 0; ai < 2; ++ai)
#pragma unroll
            for (int m = 0; m < 4; ++m) {
                const int row = u.pm * BM + ai * HALF + wr * 64 + m * 16 + fr;
                const float* xi = row < MP ? xp + (size_t)row * DM : xs + (size_t)(row - MP) * DM;
                float* xo = row < MP ? out + OUT_Y_P + (size_t)row * DM : out + OUT_Y_S + (size_t)(row - MP) * DM;
                float q = 0.f;
#pragma unroll
                for (int bj = 0; bj < 2; ++bj) { const int col = col0 + bj * HALF;
                    const f32x4 a0 = *(const f32x4*)(xi + col) + acc[ai][bj][m][0], a1 = *(const f32x4*)(xi + col + 4) + acc[ai][bj][m][1];
                    *(f32x4*)(xo + col) = a0; *(f32x4*)(xo + col + 4) = a1; *(u32x4*)(xb + (size_t)row * DM + col) = pack8(a0, a1); q += dot4(a0) + dot4(a1); }
                q += __shfl_xor(q, 16); q += __shfl_xor(q, 32);
                if (fq == 0) unsafeAtomicAdd(ssq + row, q);
                if (m & 1) asm volatile("" ::: "memory");
            }
    }
};
struct EpiB1 {
    static constexpr bool PERM = true, AFTER_DRAIN = false, KHOOK = false;
    bf16_t *q, *k, *v, *g; const float* ssq; const float *xc, *xs;
    __device__ __forceinline__ void operator()(const f32x4 (&acc)[2][2][4][2], const Unit& u, int wr, int wc, int fr, int fq) const {
        const int pn = u.pn, c0 = wc * 32 + 8 * fq;
#pragma unroll
        for (int ai = 0; ai < 2; ++ai)
#pragma unroll
            for (int m = 0; m < 4; ++m) {
                const int row = u.pm * BM + ai * HALF + wr * 64 + m * 16 + fr, pos = row_pos(row);
                const float r = 1.0f / sqrtf(ssq[row] * (1.f / DM) + NORM_EPS);
                if (pn < 16) {
                    bf16_t* dst = (pn < 8 ? q : k) + (size_t)row * DM + (pn & 7) * 256 + c0; const float ks = (pn < 8 ? 1.0f : 0.0625f) * r;
                    f32x4 o1[2], o2[2];
#pragma unroll
                    for (int n = 0; n < 2; ++n) { const f32x4 c = *(const f32x4*)(xc + pos * 128 + c0 + 4 * n), s = *(const f32x4*)(xs + pos * 128 + c0 + 4 * n);
                        const f32x4 x1 = acc[ai][0][m][n] * ks, x2 = acc[ai][1][m][n] * ks; o1[n] = x1 * c - x2 * s; o2[n] = x1 * s + x2 * c; }
                    *(u32x4*)dst = pack8(o1[0], o1[1]); *(u32x4*)(dst + HALF) = pack8(o2[0], o2[1]);
                } else {
                    const bool isg = pn >= 32; bf16_t* dst = (isg ? g : v) + (size_t)row * BV + (pn - (isg ? 32 : 16)) * 256 + c0;
#pragma unroll
                    for (int bj = 0; bj < 2; ++bj) { f32x4 v0 = acc[ai][bj][m][0] * r, v1 = acc[ai][bj][m][1] * r; if (isg) { v0 = silu4(v0); v1 = silu4(v1); }
                        *(u32x4*)(dst + bj * HALF) = pack8(v0, v1); }
                }
            }
    }
};
struct EpiB2 {
    static constexpr bool PERM = true, AFTER_DRAIN = false, KHOOK = true;
    float* out; const float* ssqR;
    __device__ __forceinline__ void khook(f32x4 (&acc)[2][2][4][2], const Unit& u, int h, int wr, int fr) const {
        typedef float f32x2 __attribute__((ext_vector_type(2)));
        __builtin_amdgcn_sched_barrier(0);
        int z_ = 0; asm volatile("v_mov_b32 %0, 0" : "=v"(z_));
        const int fr_ = (int)__builtin_amdgcn_mbcnt_hi(~0u, __builtin_amdgcn_mbcnt_lo(~0u, (unsigned)z_)) & 15;
        const float* qb = ssqR + (size_t)(u.pm * BM + wr * 64 + fr_) * 16 + h * 2;
#pragma unroll
        for (int ai = 0; ai < 2; ++ai)
#pragma unroll
            for (int m = 0; m < 4; ++m) {
                const float* q = qb + (ai * HALF + m * 16) * 16;
                const f32x2 cur = *(const f32x2*)q, prv = *(const f32x2*)(q - 2);
                const float f = sqrtf(((cur.x + cur.y) * (1.f / 512.f) + NORM_EPS) / ((prv.x + prv.y) * (1.f / 512.f) + NORM_EPS));
#pragma unroll
                for (int bj = 0; bj < 2; ++bj)
#pragma unroll
                    for (int n = 0; n < 2; ++n) acc[ai][bj][m][n] *= f;
                asm volatile("" : "+v"(acc[ai][0][m][0]), "+v"(acc[ai][0][m][1]), "+v"(acc[ai][1][m][0]), "+v"(acc[ai][1][m][1]) :: "memory");
            }
        __builtin_amdgcn_sched_barrier(0);
    }
    __device__ __forceinline__ void operator()(const f32x4 (&acc)[2][2][4][2], const Unit& u, int wr, int wc, int fr, int fq) const {
        const int col0 = u.pn * BM + wc * 32 + 8 * fq;
#pragma unroll
        for (int ai = 0; ai < 2; ++ai)
#pragma unroll
            for (int m = 0; m < 4; ++m) {
                const int row = u.pm * BM + ai * HALF + wr * 64 + m * 16 + fr; const float* q = ssqR + (size_t)row * 16 + 14;
                const float r7 = 1.0f / sqrtf((q[0] + q[1]) * (1.f / 512.f) + NORM_EPS);
                float* xo = row < MP ? out + OUT_Y_P + (size_t)row * DM : out + OUT_Y_S + (size_t)(row - MP) * DM;
#pragma unroll
                for (int bj = 0; bj < 2; ++bj) { const int col = col0 + bj * HALF;
                    *(f32x4*)(xo + col) = *(const f32x4*)(xo + col) + acc[ai][bj][m][0] * r7; *(f32x4*)(xo + col + 4) = *(const f32x4*)(xo + col + 4) + acc[ai][bj][m][1] * r7; }
                if (m & 1) asm volatile("" ::: "memory");
            }
    }
};
template <class Epi, class Sched, bool ALIGN_EPI = false, bool SP2 = false>
__device__ __forceinline__ void gemm_phase(PG8_LAS unsigned char* lds, const Gemm g, const Sched& S, const Epi& E) {
    const int tid = threadIdx.x, wid = __builtin_amdgcn_readfirstlane(tid >> 6), lane = tid & 63, wr = wid >> 2, wc = wid & 3, fr = lane & 15, fq = lane >> 4;
    const int K = g.K, nt = K / BK;
    unsigned voffA[2], voffB[2];
#pragma unroll
    for (int i = 0; i < 2; ++i) { int R, C; stage_rc(tid * 16 + i * 8192, R, C); const int Rb = Epi::PERM ? ((R & ~31) + perm32(R & 31)) : R;
        voffA[i] = (unsigned)(R * K + C) * 2u; voffB[i] = (unsigned)(Rb * K + C) * 2u; }
    const size_t kstep = (size_t)(BK * 2);
    const size_t hstep = (size_t)HALF * K * 2;
    const size_t tstep = 2 * hstep;
    const unsigned ldsw = (unsigned)wid * 1024u;
    const int aoff = lds_byte(wr * 64 + fr, fq * 8), boff = lds_byte(wc * 32 + fr, fq * 8);
#define PG8_SA(b, h) (((b) * 2 + (h)) * HTB)
#define PG8_SB(b, h) ((4 + (b) * 2 + (h)) * HTB)
#define PG8_STAGE(bufoff, gbase, voff) do { _Pragma("unroll") for (int _i = 0; _i < 2; ++_i) \
        __builtin_amdgcn_global_load_lds((const unsigned*)((const char*)(gbase) + (voff)[_i]), (PG8_LAS unsigned*)(lds + (bufoff) + ldsw + _i * 8192), 16, 0, 0); } while (0)
#define PG8_LDA(dst, b, h) do { _Pragma("unroll") for (int m = 0; m < 4; ++m) _Pragma("unroll") for (int k = 0; k < 2; ++k) dst[m][k] = *(const PG8_LAS bf16x8*)(lds + PG8_SA(b, h) + aoff + m * 2048 + k * 1024); } while (0)
#define PG8_LDB(dst, b, h) do { _Pragma("unroll") for (int n = 0; n < 2; ++n) _Pragma("unroll") for (int k = 0; k < 2; ++k) dst[n][k] = *(const PG8_LAS bf16x8*)(lds + PG8_SB(b, h) + boff + n * 2048 + k * 1024); } while (0)
#define PG8_MMA(ai, bj, At, Bt) do { __builtin_amdgcn_s_setprio(1); _Pragma("unroll") for (int m = 0; m < 4; ++m) _Pragma("unroll") for (int n = 0; n < 2; ++n) _Pragma("unroll") for (int k = 0; k < 2; ++k) \
        acc[ai][bj][m][n] = __builtin_amdgcn_mfma_f32_16x16x32_bf16(Bt[n][k], At[m][k], acc[ai][bj][m][n], 0, 0, 0); __builtin_amdgcn_s_setprio(0); } while (0)
#define PG8_WAIT_V(n) asm volatile("s_waitcnt vmcnt(" #n ")" ::: "memory")
#define PG8_WAIT_L(n) asm volatile("s_waitcnt lgkmcnt(" #n ")" ::: "memory")
#define PG8_BAR __builtin_amdgcn_s_barrier()
#define PG8_SCHED __builtin_amdgcn_sched_barrier(0)
    Unit cur, nxt; int ui = 0;
    if (!S.next(0, cur)) return;
    f32x4 acc[2][2][4][2];
#pragma unroll
    for (int a = 0; a < 2; ++a)
#pragma unroll
        for (int b = 0; b < 2; ++b)
#pragma unroll
            for (int m = 0; m < 4; ++m)
#pragma unroll
                for (int n = 0; n < 2; ++n) acc[a][b][m][n] = (f32x4){0.f, 0.f, 0.f, 0.f};
    bf16x8 At[4][2], B0[2][2], B1[2][2];
    const char* cA = (const char*)g.A + (size_t)cur.pm * tstep; const char* cB = (const char*)g.Bt + (size_t)cur.pn * tstep;
    S.a_ready(cur);
    if constexpr (SP2) {
        PG8_STAGE(PG8_SB(0, 0), cB, voffB); PG8_STAGE(PG8_SB(0, 1), cB + hstep, voffB); PG8_STAGE(PG8_SA(0, 0), cA, voffA); PG8_STAGE(PG8_SA(0, 1), cA + hstep, voffA);
        if (wr == 1) PG8_BAR;
        PG8_WAIT_V(2); PG8_BAR;
        PG8_STAGE(PG8_SB(1, 0), cB + kstep, voffB); PG8_STAGE(PG8_SA(1, 0), cA + kstep, voffA); PG8_STAGE(PG8_SB(1, 1), cB + hstep + kstep, voffB);
        PG8_WAIT_V(6); PG8_BAR;
    } else {
        PG8_STAGE(PG8_SB(0, 0), cB, voffB); PG8_STAGE(PG8_SA(0, 0), cA, voffA); PG8_STAGE(PG8_SB(0, 1), cB + hstep, voffB); PG8_STAGE(PG8_SA(0, 1), cA + hstep, voffA);
        if (wr == 1) PG8_BAR;
        PG8_WAIT_V(4); PG8_BAR;
        PG8_STAGE(PG8_SB(1, 0), cB + kstep, voffB); PG8_STAGE(PG8_SA(1, 0), cA + kstep, voffA); PG8_STAGE(PG8_SB(1, 1), cB + hstep + kstep, voffB);
        PG8_WAIT_V(6); PG8_BAR;
    }
    for (;;) {
        const bool has_next = S.next(ui + 1, nxt);
        const char* nA = has_next ? (const char*)g.A + (size_t)nxt.pm * tstep : cA; const char* nB = has_next ? (const char*)g.Bt + (size_t)nxt.pn * tstep : cB;
        for (int t = 0; t < nt; t += 2) {
            const bool last = (t == nt - 2);
            if constexpr (Epi::KHOOK) { if ((t & 7) == 0 && t != 0) E.khook(acc, cur, t >> 3, wr, fr); }
            const char* a1 = cA + (size_t)(t + 1) * kstep;
            const char* a2 = last ? nA : cA + (size_t)(t + 2) * kstep; const char* b2 = last ? nB : cB + (size_t)(t + 2) * kstep;
            const char* a3 = a2 + kstep; const char* b3 = b2 + kstep;
            if (last && has_next) S.a_ready(nxt);
            if constexpr (SP2) {
            PG8_LDB(B0, 0, 0); PG8_LDB(B1, 0, 1); PG8_SCHED; PG8_LDA(At, 0, 0); PG8_STAGE(PG8_SA(1, 1), a1 + hstep, voffA);
            PG8_WAIT_V(8); PG8_WAIT_L(0); PG8_BAR; PG8_MMA(0, 0, At, B0); PG8_MMA(0, 1, At, B1); PG8_BAR; PG8_SCHED;
            PG8_LDA(At, 0, 1); PG8_STAGE(PG8_SB(0, 0), b2, voffB); PG8_STAGE(PG8_SB(0, 1), b2 + hstep, voffB); PG8_STAGE(PG8_SA(0, 0), a2, voffA);
            PG8_WAIT_V(8); PG8_WAIT_L(0); PG8_BAR; PG8_MMA(1, 0, At, B0); PG8_MMA(1, 1, At, B1); PG8_BAR; PG8_SCHED;
            PG8_LDB(B0, 1, 0); PG8_LDB(B1, 1, 1); PG8_SCHED; PG8_LDA(At, 1, 0); PG8_STAGE(PG8_SA(0, 1), a2 + hstep, voffA);
            PG8_WAIT_V(8); PG8_WAIT_L(0); PG8_BAR; PG8_MMA(0, 0, At, B0); PG8_MMA(0, 1, At, B1); PG8_BAR; PG8_SCHED;
            PG8_LDA(At, 1, 1); PG8_STAGE(PG8_SB(1, 0), b3, voffB); PG8_STAGE(PG8_SB(1, 1), b3 + hstep, voffB); PG8_STAGE(PG8_SA(1, 0), a3, voffA);
            PG8_WAIT_V(8); PG8_WAIT_L(0); PG8_BAR; PG8_MMA(1, 0, At, B0); PG8_MMA(1, 1, At, B1); PG8_BAR; PG8_SCHED;
            } else {
            PG8_LDB(B0, 0, 0); PG8_SCHED; PG8_LDA(At, 0, 0); PG8_STAGE(PG8_SA(1, 1), a1 + hstep, voffA);
            PG8_WAIT_L(8); PG8_BAR; PG8_WAIT_L(0); PG8_MMA(0, 0, At, B0); PG8_BAR; PG8_SCHED;
            PG8_LDB(B1, 0, 1); PG8_STAGE(PG8_SB(0, 0), b2, voffB);
            PG8_BAR; PG8_WAIT_L(0); PG8_MMA(0, 1, At, B1); PG8_BAR;
            PG8_LDA(At, 0, 1); PG8_STAGE(PG8_SA(0, 0), a2, voffA);
            PG8_BAR; PG8_WAIT_L(0); PG8_MMA(1, 0, At, B0); PG8_BAR; PG8_SCHED;
            PG8_STAGE(PG8_SB(0, 1), b2 + hstep, voffB);
            PG8_WAIT_V(6); PG8_BAR; PG8_MMA(1, 1, At, B1); PG8_BAR;
            PG8_LDB(B0, 1, 0); PG8_SCHED; PG8_LDA(At, 1, 0); PG8_STAGE(PG8_SA(0, 1), a2 + hstep, voffA);
            PG8_WAIT_L(8); PG8_BAR; PG8_WAIT_L(0); PG8_MMA(0, 0, At, B0); PG8_BAR; PG8_SCHED;
            PG8_LDB(B1, 1, 1); PG8_STAGE(PG8_SB(1, 0), b3, voffB);
            PG8_BAR; PG8_WAIT_L(0); PG8_MMA(0, 1, At, B1); PG8_BAR;
            PG8_LDA(At, 1, 1); PG8_STAGE(PG8_SA(1, 0), a3, voffA);
            PG8_BAR; PG8_WAIT_L(0); PG8_MMA(1, 0, At, B0); PG8_BAR; PG8_SCHED;
            PG8_STAGE(PG8_SB(1, 1), b3 + hstep, voffB);
            PG8_WAIT_V(6); PG8_BAR; PG8_MMA(1, 1, At, B1); PG8_BAR;
            }
        }
        if constexpr (ALIGN_EPI) { if (wr == 0) PG8_BAR; }
        if constexpr (!Epi::AFTER_DRAIN) { E(acc, cur, wr, wc, fr, fq); S.done(cur); }
        if (!has_next) break;
#pragma unroll
        for (int a = 0; a < 2; ++a)
#pragma unroll
            for (int b = 0; b < 2; ++b)
#pragma unroll
                for (int m = 0; m < 4; ++m)
#pragma unroll
                    for (int n = 0; n < 2; ++n) acc[a][b][m][n] = (f32x4){0.f, 0.f, 0.f, 0.f};
        cur = nxt; cA = nA; cB = nB; ++ui;
        if constexpr (ALIGN_EPI) { if (wr == 1) PG8_BAR; }
    }
    PG8_WAIT_V(0);
    if constexpr (!ALIGN_EPI) { if (wr == 0) PG8_BAR; }
    PG8_BAR;
    if constexpr (Epi::AFTER_DRAIN) { E.fused(acc, cur, wr, wc, fr, fq, lds, wid, lane); S.done(cur); }
#undef PG8_SA
#undef PG8_SB
#undef PG8_STAGE
#undef PG8_LDA
#undef PG8_LDB
#undef PG8_MMA
#undef PG8_WAIT_V
#undef PG8_WAIT_L
#undef PG8_BAR
#undef PG8_SCHED
}
}
#ifndef HAVE_ATT
#define HAVE_ATT 0
#endif
#ifndef HAVE_RET
#define HAVE_RET 0
#endif
#ifndef PH_MASK
#define PH_MASK 0xFF
#endif
#define PH_EN(k) (((PH_MASK) >> (k)) & 1)
struct Args { Ptrs P; int ph_lo, ph_hi; };
__global__ void __launch_bounds__(NWAVES * 64, 2) mega(Args args) {
    extern __shared__ __attribute__((aligned(16))) unsigned char lds[];
    const Ptrs& P = args.P;
    const int tid = threadIdx.x, lane = tid & 63, wave = __builtin_amdgcn_readfirstlane(tid >> 6);
    const int G = gridDim.x, bx = blockIdx.x, vcu = (G % 8 == 0) ? (bx % 8) * (G / 8) + bx / 8 : bx;
    LAS unsigned char* L = (LAS unsigned char*)lds;
    volatile LAS unsigned* MISC = (volatile LAS unsigned*)(L + MISC_OFF);
    for (int u = tid; u < (LDS_BYTES - RING_BYTES) / 4; u += NWAVES * 64) ((LAS unsigned*)(L + RING_BYTES))[u] = 0u;
    __syncthreads();
    const int lo = args.ph_lo, hi = args.ph_hi;
    const bool multi = hi - lo > 1;
    XcdBarrier bar; bar.bar = (unsigned*)(P.ws + WS_CTL) + CW_BAR; bar.x = 0; bar.st = nullptr;
    if (multi) bar = xcd_barrier_post((unsigned*)(P.ws + WS_CTL) + CW_BAR, MISC + 8);
#define IN(k) (lo <= (k) && (k) < hi)
#define BOTH(k) (IN(k) && IN((k) + 1))
    const int gw = vcu * NWAVES + wave, ngw = G * NWAVES;
    unsigned char* ws = P.ws;
    bf16_t* XN0 = (bf16_t*)(ws + WS_XN0); bf16_t* Q0 = (bf16_t*)(ws + WS_Q0); bf16_t* K0 = (bf16_t*)(ws + WS_K0); bf16_t* V0 = (bf16_t*)(ws + WS_V0); bf16_t* GR = (bf16_t*)(ws + WS_GR);
    if (IN(0)) { p0_prologue(P, (LAS float*)(L + wave * 16384), gw, ngw, lane); if (BOTH(0)) xcd_barrier(bar); }
    if (PH_EN(1) && IN(1)) {
        pg8::Gemm g{XN0, (const bf16_t*)(ws + WS_WINA), MT, NA_IN, DM}; pg8::StaticOrder S; S.init(MT, NA_IN, G, bx);
        pg8::EpiA1 E{Q0, P.out, (const float*)(ws + WS_ROPE), (const float*)(ws + WS_ROPE) + 2048 * 8};
        pg8::gemm_phase<pg8::EpiA1, pg8::StaticOrder, true, true>(L, g, S, E);
        if (BOTH(1)) xcd_barrier(bar);
    }
#if HAVE_ATT
    if (IN(2)) { attn_phase(P, lds, vcu, G); if (BOTH(2)) xcd_barrier(bar); }
#endif
    if (PH_EN(3) && IN(3)) {
        pg8::Gemm g{XN0, (const bf16_t*)(ws + WS_WOUTA), MT, DM, DM}; pg8::StaticOrder S; S.init(MT, DM, G, bx);
        pg8::EpiA2 E{P.x_p, P.x_s, P.out, Q0, (float*)(ws + WS_SSQ1)};
        pg8::gemm_phase<pg8::EpiA2, pg8::StaticOrder, true, true>(L, g, S, E);
        if (BOTH(3)) xcd_barrier(bar);
    }
    if (PH_EN(4) && IN(4)) {
        pg8::Gemm g{Q0, (const bf16_t*)(ws + WS_WINB), MT, NB_IN, DM}; pg8::StaticOrder S; S.init(MT, NB_IN, G, bx);
        pg8::EpiB1 E{XN0, K0, V0, GR, (const float*)(ws + WS_SSQ1), (const float*)(ws + WS_XPOS), (const float*)(ws + WS_XPOS) + 2048 * 128};
        pg8::gemm_phase<pg8::EpiB1, pg8::StaticOrder, true, true>(L, g, S, E);
        if (BOTH(4)) xcd_barrier(bar);
    }
#if HAVE_RET
    if (IN(5)) { ret_phase(P, lds, vcu, G); if (BOTH(5)) xcd_barrier(bar); }
#endif
    if (PH_EN(6) && IN(6)) {
        pg8::Gemm g{GR, (const bf16_t*)(ws + WS_WOUTB), MT, DM, BV}; pg8::StaticOrder S; S.init(MT, DM, G, bx);
        pg8::EpiB2 E{P.out, (const float*)(ws + WS_SSQR)};
        pg8::gemm_phase<pg8::EpiB2, pg8::StaticOrder, true, true>(L, g, S, E);
        if (BOTH(6)) xcd_barrier(bar);
    }
    if (IN(7)) { p7_final(P, gw, ngw, fresh_lane()); }
#undef IN
#undef BOTH
}
#ifndef FAST_MASK
#define FAST_MASK 0
#endif
extern "C" void kernel_launch(void* const* d_in, const int* in_sizes, int n_in, void* d_out, int out_size, void* d_ws, size_t ws_size, hipStream_t stream) {
    static int grid = 0;
    if (grid == 0) {
        if (n_in != 17 || (size_t)out_size != OUT_TOTAL || ws_size < WS_END) { fprintf(stderr, "kernel_launch: unexpected sizes n_in %d out %d ws %zu (need %zu)\n", n_in, out_size, ws_size, (size_t)WS_END); grid = -1; return; }
        int dev = 0, cus = 0;
        if (hipGetDevice(&dev) != hipSuccess || hipDeviceGetAttribute(&cus, hipDeviceAttributeMultiprocessorCount, dev) != hipSuccess) { grid = -1; return; }
        if (hipFuncSetAttribute((const void*)mega, hipFuncAttributeMaxDynamicSharedMemorySize, LDS_BYTES) != hipSuccess) { fprintf(stderr, "kernel_launch: hipFuncSetAttribute failed\n"); grid = -1; return; }
        int per_cu = 0;
        if (hipOccupancyMaxActiveBlocksPerMultiprocessor(&per_cu, (const void*)mega, NWAVES * 64, LDS_BYTES) != hipSuccess || per_cu < 1) fprintf(stderr, "kernel_launch: occupancy query says %d\n", per_cu);
        (void)hipGetLastError();
        grid = cus;
    }
    if (grid < 0) return;
    Args a{};
    const float** pp = (const float**)&a.P;
    for (int i = 0; i < 17; ++i) pp[i] = (const float*)d_in[i];
    a.P.out = (float*)d_out; a.P.ws = (unsigned char*)d_ws;
    const Ptrs& P = a.P; unsigned char* ws = a.P.ws;
    hipMemsetAsync(ws + WS_CTL, 0, CTL_ZERO_BYTES, stream);
    auto run = [&](int lo, int hi) { a.ph_lo = lo; a.ph_hi = hi; hipLaunchKernelGGL(mega, dim3(grid), dim3(NWAVES * 64), LDS_BYTES, stream, a); };
#if FAST_MASK == 0xFF
    run(0, 8);
#else
    bf16_t* XN0 = (bf16_t*)(ws + WS_XN0); bf16_t* Q0 = (bf16_t*)(ws + WS_Q0); bf16_t* K0 = (bf16_t*)(ws + WS_K0); bf16_t* V0 = (bf16_t*)(ws + WS_V0); bf16_t* GR = (bf16_t*)(ws + WS_GR);
    run(0, 1);
    if (FAST_MASK & 2) run(1, 2);
    else { { orc::ERaw e{Q0, 2048, 2048, ACT / 2, nullptr}; hipLaunchKernelGGL(orc::s_gemm<orc::ERaw>, dim3(NA_IN / 64, MT / 64), dim3(256), 0, stream, XN0, (const bf16_t*)(ws + WS_WINA), DM, e); }
        hipLaunchKernelGGL(orc::s_post1, dim3((unsigned)(((size_t)MT * NA_IN + 255) / 256)), dim3(256), 0, stream, P); }
    if (FAST_MASK & 4) run(2, 3);
    else { hipLaunchKernelGGL(orc::s_attn, dim3(MP, 16), dim3(128), 0, stream, P, 0); hipLaunchKernelGGL(orc::s_attn, dim3(MS, 16), dim3(128), 0, stream, P, 1); }
    if (FAST_MASK & 8) run(3, 4);
    else { { orc::ERes1 e{P.x_p, P.x_s, P.out, Q0}; hipLaunchKernelGGL(orc::s_gemm<orc::ERes1>, dim3(DM / 64, MT / 64), dim3(256), 0, stream, XN0, (const bf16_t*)(ws + WS_WOUTA), DM, e); }
        hipLaunchKernelGGL(orc::s_rowssq, dim3(MT / 4), dim3(256), 0, stream, P); }
    if (FAST_MASK & 16) run(4, 5);
    else { { orc::ERaw3 e{XN0, K0, V0, GR, (const float*)(ws + WS_SSQ1)}; hipLaunchKernelGGL(orc::s_gemm<orc::ERaw3>, dim3(NB_IN / 64, MT / 64), dim3(256), 0, stream, Q0, (const bf16_t*)(ws + WS_WINB), DM, e); }
        hipLaunchKernelGGL(orc::s_post3, dim3((unsigned)(((size_t)MT * NB_IN + 255) / 256)), dim3(256), 0, stream, P); }
    if (FAST_MASK & 32) run(5, 6);
    else hipLaunchKernelGGL(orc::s_ret, dim3(8, 8, 32), dim3(256), 0, stream, P);
    if (FAST_MASK & 64) run(6, 7);
    else { hipLaunchKernelGGL(orc::s_norm_o1, dim3((unsigned)(((size_t)MT * BV + 255) / 256)), dim3(256), 0, stream, P);
        { orc::ERes2 e{P.out}; hipLaunchKernelGGL(orc::s_gemm<orc::ERes2>, dim3(DM / 64, MT / 64), dim3(256), 0, stream, GR, (const bf16_t*)(ws + WS_WOUTB), BV, e); } }
    run(7, 8);
#endif
}
```

```cpp
#define FAST_MASK 0x5E
#define HAVE_ATT 1
#include <hip/hip_runtime.h>
#include <cstdio>
#include <cstdint>

constexpr int DM = 2048, SEQ = 2048, NB = 16, DSEQ = 16, PAST = 1024;
constexpr int MP = NB * SEQ;
constexpr int MS = NB * DSEQ;
constexpr int MT = MP + MS;
constexpr int NA_IN = 8192, NB_IN = 12288, BV = 4096;
constexpr float QSCALE = 0.125f * 1.4426950408889634f;
constexpr float LAMBDA_INIT = 0.2f;
constexpr float NORM_EPS = 1e-6f, SUBLN_EPS = 1e-5f;

constexpr size_t OUT_Y_P = 0, OUT_Y_S = OUT_Y_P + (size_t)MP * DM, OUT_K_P = OUT_Y_S + (size_t)MS * DM, OUT_V_P = OUT_K_P + (size_t)MP * DM,
                 OUT_ST_P = OUT_V_P + (size_t)MP * DM, OUT_K_S = OUT_ST_P + (size_t)NB * 8 * 256 * 512, OUT_V_S = OUT_K_S + (size_t)MS * DM,
                 OUT_ST_S = OUT_V_S + (size_t)MS * DM, OUT_TOTAL = OUT_ST_S + (size_t)NB * 8 * 256 * 512;

constexpr size_t MiB = 1u << 20;
constexpr size_t WS_CTL = 0, CTL_ZERO_BYTES = 7 * MiB;
constexpr size_t WS_SSQ1 = 256 * 1024;
constexpr size_t WS_SSQR = 4 * MiB;
constexpr size_t WS_ROPE = 1 * MiB;
constexpr size_t WS_XPOS = 2 * MiB;
constexpr size_t WS_LAM = 7 * MiB;
constexpr size_t WS_WINA = 8 * MiB, WS_WOUTA = 40 * MiB, WS_WINB = 48 * MiB, WS_WOUTB = 96 * MiB;
constexpr size_t ACT = (size_t)MT * DM * 2;
constexpr size_t WS_XN0 = 112 * MiB;
constexpr size_t WS_Q0 = WS_XN0 + ACT;
constexpr size_t WS_K0 = WS_Q0 + ACT;
constexpr size_t WS_V0 = WS_K0 + ACT;
constexpr size_t WS_G0 = WS_V0 + ACT;
constexpr size_t WS_GR = WS_G0 + ACT;
constexpr size_t WS_END = WS_GR + 2 * ACT;
static_assert(WS_END == 1015 * MiB, "ws map");
constexpr int CW_BAR = 4096;

typedef unsigned short bf16_t;
typedef short bf16x8 __attribute__((ext_vector_type(8)));
typedef float f32x4 __attribute__((ext_vector_type(4)));
typedef float f32x16 __attribute__((ext_vector_type(16)));
typedef unsigned u32x4 __attribute__((ext_vector_type(4)));
typedef unsigned u32x2 __attribute__((ext_vector_type(2)));

__device__ __forceinline__ unsigned f2bf(float f) { unsigned u = __builtin_bit_cast(unsigned, f); return (u + 0x7fffu + ((u >> 16) & 1u)) >> 16; }
__device__ __forceinline__ float bf2f(unsigned short b) { return __builtin_bit_cast(float, (unsigned)b << 16); }
__device__ __forceinline__ unsigned pk2(float lo, float hi) { return f2bf(lo) | (f2bf(hi) << 16); }
__device__ __forceinline__ float silu_f(float x) { return x * __builtin_amdgcn_rcpf(1.0f + __builtin_amdgcn_exp2f(-1.4426950408889634f * x)); }
__device__ __forceinline__ float wave_sum(float v) {
#pragma unroll
    for (int o = 1; o < 64; o <<= 1) v += __shfl_xor(v, o);
    return v;
}
__device__ __forceinline__ int row_pos(int row) { return row < MP ? (row & (SEQ - 1)) : PAST + ((row - MP) & (DSEQ - 1)); }

struct Ptrs {
    const float *x_p, *x_s, *ck, *cv, *st, *norm_a, *w_in_a, *lq1, *lk1, *lq2, *lk2, *subln, *w_out_a, *norm_b, *w_in_b, *w_out_b, *norm_f;
    float* out; unsigned char* ws;
};
#define LAS __attribute__((address_space(3)))
#define GAS __attribute__((address_space(1)))
__device__ __forceinline__ void p0_transpose_item(const float* W, const float* gain, int K, int N, bf16_t* WT, LAS float* scr, int item, int lane) {
    const int nblk = N / 32, kb = item / nblk, nb = item % nblk, k0 = 64 * kb, n0 = 32 * nb;
#pragma unroll 8
    for (int i = 0; i < 32; ++i) { const int kk = 2 * i + (lane >> 5); float w = W[(size_t)(k0 + kk) * N + n0 + (lane & 31)]; if (gain) w *= gain[k0 + kk]; scr[kk * 33 + (lane & 31)] = w; }
    asm volatile("s_waitcnt lgkmcnt(0)" ::: "memory");
    const int c = lane & 7;
#pragma unroll
    for (int j = 0; j < 4; ++j) { const int n = (lane >> 3) + 8 * j; const LAS float* s = scr + (8 * c) * 33 + n;
        u32x4 o; o.x = pk2(s[0 * 33], s[1 * 33]); o.y = pk2(s[2 * 33], s[3 * 33]); o.z = pk2(s[4 * 33], s[5 * 33]); o.w = pk2(s[6 * 33], s[7 * 33]);
        *(u32x4*)(WT + (size_t)(n0 + n) * K + k0 + 8 * c) = o; }
    asm volatile("s_waitcnt lgkmcnt(0)" ::: "memory");
}
__device__ __forceinline__ void p0_norm_row(const float* xrow, const float* g, bf16_t* orow, int lane) {
    const f32x4* xr = (const f32x4*)xrow + lane; const f32x4* gr = (const f32x4*)g + lane;
    f32x4 v[8]; float s = 0.f;
#pragma unroll
    for (int j = 0; j < 8; ++j) { v[j] = xr[64 * j]; s += (v[j].x * v[j].x + v[j].y * v[j].y) + (v[j].z * v[j].z + v[j].w * v[j].w); }
    const float r = 1.0f / sqrtf(wave_sum(s) * (1.f / DM) + NORM_EPS);
    u32x2* o8 = (u32x2*)orow + lane;
#pragma unroll
    for (int j = 0; j < 8; ++j) { const f32x4 gg = gr[64 * j]; u32x2 w; w.x = pk2(v[j].x * r * gg.x, v[j].y * r * gg.y); w.y = pk2(v[j].z * r * gg.z, v[j].w * r * gg.w); o8[64 * j] = w; }
}
__device__ __forceinline__ void sincos_rev(float angle, float& c, float& s) {
    const double rev = (double)angle * 0.15915494309189533577; const float fr = (float)(rev - __builtin_rint(rev));
    c = __builtin_amdgcn_cosf(fr); s = __builtin_amdgcn_sinf(fr);
}
__device__ __forceinline__ void p0_prologue(const Ptrs& P, LAS float* scr, int gw, int ngw, int lane) {
    unsigned char* ws = P.ws;
    constexpr int I_INA = (DM / 64) * (NA_IN / 32), I_OUTA = (DM / 64) * (DM / 32), I_INB = (DM / 64) * (NB_IN / 32), I_OUTB = (BV / 64) * (DM / 32);
    constexpr int NITEMS = I_INA + I_OUTA + I_INB + I_OUTB;
    for (int it = gw; it < NITEMS; it += ngw) {
        int r = it;
        if (r < I_INA) { p0_transpose_item(P.w_in_a, nullptr, DM, NA_IN, (bf16_t*)(ws + WS_WINA), scr, r, lane); continue; } r -= I_INA;
        if (r < I_OUTA) { p0_transpose_item(P.w_out_a, nullptr, DM, DM, (bf16_t*)(ws + WS_WOUTA), scr, r, lane); continue; } r -= I_OUTA;
        if (r < I_INB) { p0_transpose_item(P.w_in_b, P.norm_b, DM, NB_IN, (bf16_t*)(ws + WS_WINB), scr, r, lane); continue; } r -= I_INB;
        p0_transpose_item(P.w_out_b, nullptr, BV, DM, (bf16_t*)(ws + WS_WOUTB), scr, r, lane);
    }
    bf16_t* XN = (bf16_t*)(ws + WS_XN0);
    for (int m = gw; m < MT; m += ngw) p0_norm_row(m < MP ? P.x_p + (size_t)m * DM : P.x_s + (size_t)(m - MP) * DM, P.norm_a, XN + (size_t)m * DM, lane);
    float* rc = (float*)(ws + WS_ROPE); float* rs = rc + 2048 * 8;
    for (int i = gw * 64 + lane; i < 2048 * 8; i += ngw * 64) { const int pos = i >> 3, k = i & 7;
        const float inv = (float)exp2(-18.931568569324174 * (double)k / 8.0);
        float c, s; sincos_rev((float)pos * inv, c, s); rc[i] = c; rs[i] = s; }
    float* xc = (float*)(ws + WS_XPOS); float* xs = xc + 2048 * 128;
    for (int i = gw * 64 + lane; i < 2048 * 128; i += ngw * 64) { const int pos = i >> 7, k = i & 127;
        const float e = (float)k * (1.0f / 127.0f);
        const float inv = 1.0f / (float)exp2(13.287712379549449 * (double)e);
        float c, s; sincos_rev((float)pos * inv, c, s); xc[i] = c; xs[i] = s; }
    if (gw == 0) { float a = P.lq1[lane] * P.lk1[lane], b = P.lq2[lane] * P.lk2[lane]; a = wave_sum(a); b = wave_sum(b);
        if (lane == 0) *(float*)(ws + WS_LAM) = expf(a) - expf(b) + LAMBDA_INIT; }
}
namespace orc {
template <class E>
__global__ __launch_bounds__(256) void s_gemm(const bf16_t* __restrict__ A, const bf16_t* __restrict__ Bt, int K, E e) {
    const int wave = threadIdx.x >> 6, lane = threadIdx.x & 63, l15 = lane & 15, kq = lane >> 4;
    const int row0 = blockIdx.y * 64 + (wave >> 1) * 32, col0 = blockIdx.x * 64 + (wave & 1) * 32;
    f32x4 acc[2][2];
#pragma unroll
    for (int i = 0; i < 2; ++i)
#pragma unroll
        for (int j = 0; j < 2; ++j) acc[i][j] = (f32x4){0.f, 0.f, 0.f, 0.f};
    const bf16_t* ap = A + (size_t)(row0 + l15) * K + kq * 8; const bf16_t* bp = Bt + (size_t)(col0 + l15) * K + kq * 8;
    for (int k = 0; k < K; k += 32) {
        bf16x8 a[2], b[2];
#pragma unroll
        for (int i = 0; i < 2; ++i) { a[i] = *(const bf16x8*)(ap + (size_t)i * 16 * K + k); b[i] = *(const bf16x8*)(bp + (size_t)i * 16 * K + k); }
#pragma unroll
        for (int i = 0; i < 2; ++i)
#pragma unroll
            for (int j = 0; j < 2; ++j) acc[i][j] = __builtin_amdgcn_mfma_f32_16x16x32_bf16(a[i], b[j], acc[i][j], 0, 0, 0);
    }
#pragma unroll
    for (int i = 0; i < 2; ++i)
#pragma unroll
        for (int j = 0; j < 2; ++j)
#pragma unroll
            for (int r = 0; r < 4; ++r) e(row0 + i * 16 + kq * 4 + r, col0 + j * 16 + l15, acc[i][j][r]);
}
struct ERaw { bf16_t* base; int secw, ld; size_t stride; const float* ssq;
    __device__ void operator()(int row, int col, float v) const { const int s = col / secw;
        if (ssq) v *= 1.0f / sqrtf(ssq[row] * (1.f / DM) + NORM_EPS);
        base[(size_t)s * stride + (size_t)row * ld + (col - s * secw)] = (bf16_t)f2bf(v); } };
struct ERaw3 { bf16_t *q, *k, *v, *g; const float* ssq;
    __device__ void operator()(int row, int col, float x) const { x *= 1.0f / sqrtf(ssq[row] * (1.f / DM) + NORM_EPS); const bf16_t o = (bf16_t)f2bf(x);
        if (col < 2048) q[(size_t)row * DM + col] = o; else if (col < 4096) k[(size_t)row * DM + col - 2048] = o;
        else if (col < 8192) v[(size_t)row * BV + col - 4096] = o; else g[(size_t)row * BV + col - 8192] = o; } };
struct ERes1 { const float *xp, *xs; float* out; bf16_t* xb;
    __device__ void operator()(int row, int col, float v) const {
        const float x = row < MP ? xp[(size_t)row * DM + col] : xs[(size_t)(row - MP) * DM + col];
        float* o = row < MP ? out + OUT_Y_P + (size_t)row * DM + col : out + OUT_Y_S + (size_t)(row - MP) * DM + col;
        const float r = x + v; *o = r; xb[(size_t)row * DM + col] = (bf16_t)f2bf(r); } };
struct ERes2 { float* out;
    __device__ void operator()(int row, int col, float v) const {
        float* o = row < MP ? out + OUT_Y_P + (size_t)row * DM + col : out + OUT_Y_S + (size_t)(row - MP) * DM + col; *o += v; } };

__global__ __launch_bounds__(256) void s_post1(Ptrs P) {
    const size_t idx = (size_t)blockIdx.x * 256 + threadIdx.x; if (idx >= (size_t)MT * NA_IN) return;
    const int row = (int)(idx / NA_IN), col = (int)(idx % NA_IN), sec = col >> 11, c = col & 2047, c64 = c & 63;
    bf16_t* buf = (bf16_t*)(P.ws + WS_Q0) + (size_t)sec * (ACT / 2) + (size_t)row * DM;
    const float* rc = (const float*)(P.ws + WS_ROPE); const float* rs = rc + 2048 * 8; const int pos = row_pos(row);
    float* ko = row < MP ? P.out + OUT_K_P + (size_t)row * DM : P.out + OUT_K_S + (size_t)(row - MP) * DM;
    float* vo = row < MP ? P.out + OUT_V_P + (size_t)row * DM : P.out + OUT_V_S + (size_t)(row - MP) * DM;
    if (sec <= 1) {
        if (c64 >= 8 && c64 < 16) return;
        if (c64 < 8) { const float x1 = bf2f(buf[c]), x2 = bf2f(buf[c + 8]), cs = rc[pos * 8 + c64], sn = rs[pos * 8 + c64];
            float o1 = x1 * cs - x2 * sn, o2 = x1 * sn + x2 * cs;
            if (sec == 0) { o1 *= QSCALE; o2 *= QSCALE; } else { ko[c] = o1; ko[c + 8] = o2; }
            buf[c] = (bf16_t)f2bf(o1); buf[c + 8] = (bf16_t)f2bf(o2); }
        else { float x = bf2f(buf[c]); if (sec == 0) { x *= QSCALE; buf[c] = (bf16_t)f2bf(x); } else ko[c] = x; }
    } else if (sec == 2) { vo[c] = bf2f(buf[c]); }
    else { buf[c] = (bf16_t)f2bf(silu_f(bf2f(buf[c]))); }
}
__global__ __launch_bounds__(256) void s_post3(Ptrs P) {
    const size_t idx = (size_t)blockIdx.x * 256 + threadIdx.x; if (idx >= (size_t)MT * NB_IN) return;
    const int row = (int)(idx / NB_IN), col = (int)(idx % NB_IN);
    const float* xc = (const float*)(P.ws + WS_XPOS); const float* xs = xc + 2048 * 128; const int pos = row_pos(row);
    if (col < 4096) { const int sec = col >> 11, c = col & 2047, c256 = c & 255; if (c256 >= 128) return;
        bf16_t* buf = (bf16_t*)(P.ws + (sec == 0 ? WS_XN0 : WS_K0)) + (size_t)row * DM;
        const float x1 = bf2f(buf[c]), x2 = bf2f(buf[c + 128]), cs = xc[pos * 128 + c256], sn = xs[pos * 128 + c256];
        float o1 = x1 * cs - x2 * sn, o2 = x1 * sn + x2 * cs; if (sec == 1) { o1 *= 0.0625f; o2 *= 0.0625f; }
        buf[c] = (bf16_t)f2bf(o1); buf[c + 128] = (bf16_t)f2bf(o2);
    } else if (col >= 8192) { bf16_t* g = (bf16_t*)(P.ws + WS_GR) + (size_t)row * BV + (col - 8192); *g = (bf16_t)f2bf(silu_f(bf2f(*g))); }
}
__device__ __forceinline__ float block_sum128(float v, float* red) {
    v = wave_sum(v); __syncthreads(); if ((threadIdx.x & 63) == 0) red[threadIdx.x >> 6] = v; __syncthreads(); return red[0] + red[1]; }
__device__ __forceinline__ float block_max128(float v, float* red) {
#pragma unroll
    for (int o = 1; o < 64; o <<= 1) v = fmaxf(v, __shfl_xor(v, o));
    __syncthreads(); if ((threadIdx.x & 63) == 0) red[threadIdx.x >> 6] = v; __syncthreads(); return fmaxf(red[0], red[1]); }
__global__ __launch_bounds__(128) void s_attn(Ptrs P, int sample) {
    __shared__ float sc0[2112], sc1[2112], qs[128], red[2];
    const int tid = threadIdx.x, h = blockIdx.y; int row, b, nkeys;
    if (!sample) { row = blockIdx.x; b = row >> 11; nkeys = (((row & 2047) >> 6) + 1) << 6; } else { b = blockIdx.x >> 4; row = MP + blockIdx.x; nkeys = PAST + DSEQ; }
    const bf16_t* Q0 = (const bf16_t*)(P.ws + WS_Q0); const bf16_t* K0 = (const bf16_t*)(P.ws + WS_K0); const bf16_t* V0 = (const bf16_t*)(P.ws + WS_V0); const bf16_t* G0 = (const bf16_t*)(P.ws + WS_G0);
    bf16_t* O0 = (bf16_t*)(P.ws + WS_XN0);
    qs[tid] = bf2f(Q0[(size_t)row * DM + h * 128 + tid]); __syncthreads();
    float m0 = -1e30f, m1 = -1e30f;
#pragma unroll 1
    for (int j = tid; j < nkeys; j += 128) { float s0 = 0.f, s1 = 0.f;
        if (sample && j < PAST) { const float* kr = P.ck + ((size_t)(b * PAST + j)) * DM + h * 128;
#pragma unroll 8
            for (int d = 0; d < 64; ++d) { s0 += qs[d] * kr[d]; s1 += qs[64 + d] * kr[64 + d]; } }
        else { const size_t kr_row = sample ? (size_t)(MP + b * DSEQ + (j - PAST)) : (size_t)((b << 11) + j); const bf16_t* kr = K0 + kr_row * DM + h * 128;
#pragma unroll 8
            for (int d = 0; d < 64; ++d) { s0 += qs[d] * bf2f(kr[d]); s1 += qs[64 + d] * bf2f(kr[64 + d]); } }
        sc0[j] = s0; sc1[j] = s1; m0 = fmaxf(m0, s0); m1 = fmaxf(m1, s1); }
    m0 = block_max128(m0, red); m1 = block_max128(m1, red);
    float l0 = 0.f, l1 = 0.f;
    for (int j = tid; j < nkeys; j += 128) { const float p0 = exp2f(sc0[j] - m0), p1 = exp2f(sc1[j] - m1); sc0[j] = p0; sc1[j] = p1; l0 += p0; l1 += p1; }
    l0 = block_sum128(l0, red); l1 = block_sum128(l1, red);
    const float lam = *(const float*)(P.ws + WS_LAM), i0 = 1.0f / l0, i1 = lam / l1;
    __syncthreads();
    float o = 0.f;
#pragma unroll 4
    for (int j = 0; j < nkeys; ++j) { const float a = sc0[j] * i0 - sc1[j] * i1; float v;
        if (sample && j < PAST) v = P.cv[((size_t)(b * PAST + j)) * DM + h * 128 + tid];
        else { const size_t vr = sample ? (size_t)(MP + b * DSEQ + (j - PAST)) : (size_t)((b << 11) + j); v = bf2f(V0[vr * DM + h * 128 + tid]); }
        o += a * v; }
    const float ssq = block_sum128(o * o, red);
    const float r = 1.0f / sqrtf(ssq * (1.f / 128.f) + SUBLN_EPS);
    const float res = o * r * P.subln[tid] * (1.0f - LAMBDA_INIT) * bf2f(G0[(size_t)row * DM + h * 128 + tid]);
    O0[(size_t)row * DM + h * 128 + tid] = (bf16_t)f2bf(res);
}
__global__ __launch_bounds__(256) void s_rowssq(Ptrs P) {
    const int row = blockIdx.x * 4 + (threadIdx.x >> 6), lane = threadIdx.x & 63; if (row >= MT) return;
    const float* x = row < MP ? P.out + OUT_Y_P + (size_t)row * DM : P.out + OUT_Y_S + (size_t)(row - MP) * DM; float s = 0.f;
    for (int i = lane; i < DM; i += 64) s += x[i] * x[i];
    s = wave_sum(s); if (lane == 0) ((float*)(P.ws + WS_SSQ1))[row] = s;
}
__global__ __launch_bounds__(256) void s_ret(Ptrs P) {
    __shared__ bf16_t qs[64 * 256], ks[64 * 256]; __shared__ float vs[64 * 64], sc[64 * 65], ys[64 * 64];
    const int tid = threadIdx.x, dvc = tid & 63, kq = tid >> 6, sl = blockIdx.x, h = blockIdx.y, unit = blockIdx.z;
    const bool smp = unit >= 16; const int b = unit & 15, nch = smp ? 1 : 32, L = smp ? DSEQ : 64; const size_t row0 = smp ? (size_t)MP + b * DSEQ : (size_t)b * SEQ;
    const bf16_t* Qr = (const bf16_t*)(P.ws + WS_XN0); const bf16_t* Kr = (const bf16_t*)(P.ws + WS_K0); const bf16_t* Vr = (const bf16_t*)(P.ws + WS_V0); bf16_t* Gr = (bf16_t*)(P.ws + WS_GR);
    float* ssqR = (float*)(P.ws + WS_SSQR);
    const float lg = log1pf(-exp2f(-5.0f - (float)h));
    float S[64];
    const size_t st_off = (((size_t)b * 8 + h) * 256) * 512 + sl * 64 + dvc;
#pragma unroll
    for (int i = 0; i < 64; ++i) S[i] = smp ? P.st[st_off + (size_t)(64 * kq + i) * 512] : 0.f;
    for (int c = 0; c < nch; ++c) { const size_t r0 = row0 + (size_t)c * 64;
        for (int i = tid; i < 64 * 256; i += 256) { const int t = i >> 8, d = i & 255; const bool ok = t < L;
            qs[i] = ok ? Qr[(r0 + t) * DM + h * 256 + d] : (bf16_t)0; ks[i] = ok ? Kr[(r0 + t) * DM + h * 256 + d] : (bf16_t)0; }
        for (int i = tid; i < 64 * 64; i += 256) { const int t = i >> 6, d = i & 63; vs[i] = t < L ? bf2f(Vr[(r0 + t) * BV + h * 512 + sl * 64 + d]) : 0.f; ys[i] = 0.f; }
        __syncthreads();
        for (int i = 0; i < 16; ++i) { const int id = tid * 16 + i, tq = id >> 6, tk = id & 63; float s = 0.f;
            for (int d = 0; d < 256; ++d) s += bf2f(qs[tq * 256 + d]) * bf2f(ks[tk * 256 + d]);
            sc[tq * 65 + tk] = s * expf(lg * fabsf((float)(tq - tk))); }
        for (int t = 0; t < 64; ++t) { float p = 0.f;
#pragma unroll
            for (int i = 0; i < 64; ++i) p += bf2f(qs[t * 256 + 64 * kq + i]) * S[i];
            atomicAdd(&ys[t * 64 + dvc], p * expf(lg * (float)(t + 1))); }
        __syncthreads();
        for (int t = kq * 16; t < kq * 16 + 16; ++t) { float y = ys[t * 64 + dvc];
            for (int tk = 0; tk < 64; ++tk) y += sc[t * 65 + tk] * vs[tk * 64 + dvc];
            ys[t * 64 + dvc] = y; }
        const float cd = expf(lg * (float)L);
#pragma unroll
        for (int i = 0; i < 64; ++i) S[i] *= cd;
        for (int t = 0; t < L; ++t) { const float vd = vs[t * 64 + dvc] * expf(lg * (float)(L - 1 - t));
#pragma unroll
            for (int i = 0; i < 64; ++i) S[i] += bf2f(ks[t * 256 + 64 * kq + i]) * vd; }
        for (int t = kq * 16; t < kq * 16 + 16; ++t) { const float y = ys[t * 64 + dvc]; const float q = wave_sum(y * y);
            if (t < L) { bf16_t* g = Gr + (r0 + t) * BV + h * 512 + sl * 64 + dvc; *g = (bf16_t)f2bf(y * bf2f(*g));
                if (dvc == 0) atomicAdd(&ssqR[(r0 + t) * 16 + h * 2 + (sl >> 2)], q); } }
        __syncthreads();
    }
    float* so = P.out + (smp ? OUT_ST_S : OUT_ST_P) + st_off;
#pragma unroll
    for (int i = 0; i < 64; ++i) so[(size_t)(64 * kq + i) * 512] = S[i];
}
__global__ __launch_bounds__(256) void s_norm_o1(Ptrs P) {
    const size_t idx = (size_t)blockIdx.x * 256 + threadIdx.x; if (idx >= (size_t)MT * BV) return;
    const size_t row = idx / BV; const int col = (int)(idx % BV), h = col >> 9; const float* q = (const float*)(P.ws + WS_SSQR) + row * 16 + h * 2;
    bf16_t* g = (bf16_t*)(P.ws + WS_GR) + idx; *g = (bf16_t)f2bf(bf2f(*g) / sqrtf((q[0] + q[1]) * (1.f / 512.f) + NORM_EPS));
}
}
#define XB_TMO      128
#define XB_XCNT(j)  (256  + 64 * (j))
#define XB_XSUB(j)  (1280 + 64 * (j))
#define XB_XGEN(j)  (2304 + 64 * (j))
#define XB_TOP      3328
#define XB_TOPGEN   3392
#define XCD_BAR_WORDS 3456
#define XB_SPIN_CAP (1u << 18)
__device__ __forceinline__ unsigned xb_ld(unsigned* p)              { return __hip_atomic_load(p, __ATOMIC_RELAXED, __HIP_MEMORY_SCOPE_AGENT); }
__device__ __forceinline__ unsigned xb_add(unsigned* p, unsigned v) { return __hip_atomic_fetch_add(p, v, __ATOMIC_RELAXED, __HIP_MEMORY_SCOPE_AGENT); }
__device__ __forceinline__ unsigned xb_xcc_id() { return (unsigned)__builtin_amdgcn_s_getreg((3 << 11) | 20) & 0xFu; }
#define XB_SPIN(cond, bar) do { unsigned _sp = 0; while (cond) { __builtin_amdgcn_s_sleep(1); \
    if ((++_sp & 255u) == 0u) { if (xb_ld(&(bar)[XB_TMO])) break; if (_sp > XB_SPIN_CAP) { atomicAdd(&(bar)[XB_TMO], 1u); break; } } } } while (0)
struct XcdBarrier { unsigned* bar; unsigned x; volatile LAS unsigned* st; };
__device__ __forceinline__ XcdBarrier xcd_barrier_post(unsigned* bar, volatile LAS unsigned* st) {
    XcdBarrier b; b.bar = bar; b.x = xb_xcc_id(); b.st = st;
    if (threadIdx.x == 0) (void)xb_add(&bar[XB_XCNT(b.x)], 1u);
    return b;
}
__device__ __forceinline__ void xcd_barrier_complete(unsigned* bar, unsigned x, unsigned& nloc, unsigned& nx) {
    const unsigned G = gridDim.x * gridDim.y * gridDim.z;
    unsigned sum, cnt, mine, sp = 0u;
    for (;;) {
        sum = 0u; cnt = 0u; mine = 0u;
#pragma unroll
        for (unsigned j = 0; j < 16; ++j) { const unsigned c = xb_ld(&bar[XB_XCNT(j)]); sum += c; cnt += (c > 0u) ? 1u : 0u; mine = (j == x) ? c : mine; }
        if (sum == G) break;
        __builtin_amdgcn_s_sleep(1);
        if ((++sp & 255u) == 0u) { if (xb_ld(&bar[XB_TMO])) break; if (sp > XB_SPIN_CAP) { atomicAdd(&bar[XB_TMO], 1u); break; } }
    }
    nloc = mine > 0u ? mine : 1u; nx = cnt > 0u ? cnt : 1u;
}
__device__ __forceinline__ void xcd_barrier(const XcdBarrier& b) {
    asm volatile("s_waitcnt vmcnt(0)" ::: "memory");
    __syncthreads();
    if (threadIdx.x == 0) {
        unsigned* bar = b.bar;
        __builtin_amdgcn_s_waitcnt(0);
        unsigned nloc = b.st[0], nx = b.st[1];
        if (nloc == 0u) { xcd_barrier_complete(bar, b.x, nloc, nx); b.st[0] = nloc; b.st[1] = nx; }
        const unsigned old = xb_add(&bar[XB_XSUB(b.x)], 1u);
        const unsigned gen = old / nloc;
        if (old + 1u == (gen + 1u) * nloc) {
            __builtin_amdgcn_fence(__ATOMIC_RELEASE, "agent");
            asm volatile("s_waitcnt vmcnt(0)" ::: "memory");
            const unsigned og = xb_add(&bar[XB_TOP], 1u);
            const unsigned tg = og / nx;
            if (og + 1u == (tg + 1u) * nx) xb_add(&bar[XB_TOPGEN], 1u);
            else XB_SPIN(xb_ld(&bar[XB_TOPGEN]) == tg, bar);
            __builtin_amdgcn_fence(__ATOMIC_ACQUIRE, "agent");
            xb_add(&bar[XB_XGEN(b.x)], 1u);
            asm volatile("s_waitcnt vmcnt(0)" ::: "memory");
        } else {
            XB_SPIN(xb_ld(&bar[XB_XGEN(b.x)]) == gen, bar);
            __builtin_amdgcn_fence(__ATOMIC_ACQUIRE, "agent");
            asm volatile("s_waitcnt vmcnt(0)" ::: "memory");
        }
    }
    __syncthreads();
}

constexpr int RING_BYTES = 131072;
constexpr int MISC_OFF = RING_BYTES + 320;
constexpr int LDS_BYTES = 147456;
constexpr int NWAVES = 8;

__device__ __forceinline__ int fresh_lane() { int z; asm volatile("v_mov_b32 %0, 0" : "=v"(z)); return (int)__builtin_amdgcn_mbcnt_hi(~0u, __builtin_amdgcn_mbcnt_lo(~0u, (unsigned)z)); }
__device__ __forceinline__ void p7_final(const Ptrs& P, int gw, int ngw, int lane) {
    for (int m = gw; m < MT; m += ngw) {
        float* xrow = m < MP ? P.out + OUT_Y_P + (size_t)m * DM : P.out + OUT_Y_S + (size_t)(m - MP) * DM;
        f32x4* xr = (f32x4*)xrow + lane; const f32x4* gr = (const f32x4*)P.norm_f + lane;
        f32x4 v[8]; float s = 0.f;
#pragma unroll
        for (int j = 0; j < 8; ++j) { v[j] = xr[64 * j]; s += (v[j].x * v[j].x + v[j].y * v[j].y) + (v[j].z * v[j].z + v[j].w * v[j].w); }
        const float r = 1.0f / sqrtf(wave_sum(s) * (1.f / DM) + NORM_EPS);
#pragma unroll
        for (int j = 0; j < 8; ++j) { const f32x4 gg = gr[64 * j]; xr[64 * j] = (f32x4){v[j].x * r * gg.x, v[j].y * r * gg.y, v[j].z * r * gg.z, v[j].w * r * gg.w}; }
    }
}
namespace pg8 {
#define PG8_LAS __attribute__((address_space(3)))
constexpr int BM = 256, BK = 64, HALF = 128, HTB = HALF * BK * 2  , STAGE_BYTES = 8 * HTB, NXCD = 8, WGM = 8;

__host__ __device__ __forceinline__ int lds_byte(int r, int c) { const int st = (r >> 4) * 2 + (c >> 5), rr = r & 15, cc = c & 31, ob = rr * 64 + cc * 2; return st * 1024 + (ob ^ (((ob >> 9) & 1) << 5)); }
__host__ __device__ __forceinline__ void stage_rc(int b, int& R, int& C) { const int st = b / 1024, sb = b % 1024, swz = sb ^ (((sb >> 9) & 1) << 5); R = (st >> 1) * 16 + swz / 64; C = (st & 1) * 32 + (swz % 64) / 2; }
__host__ __device__ __forceinline__ int perm32(int rho) { const int n = rho >> 4, i = rho & 15; return 8 * (i >> 2) + 4 * n + (i & 3); }

struct Unit { int pm, pn; };
struct Gemm { const bf16_t* A; const bf16_t* Bt; int M, N, K; };

struct StaticOrder {
    int nM, nN, nwg, G, c;
    __host__ __device__ void init(int M, int N, int G_, int c_) { nM = M / BM; nN = N / BM; nwg = nM * nN; G = G_; c = c_; }
    __host__ __device__ bool next(int i, Unit& u) const {
        const long L = (long)i * G + c; if (L >= nwg) return false;
        int wgid = (int)L; { const int q = nwg / NXCD, r = nwg % NXCD, xcd = wgid % NXCD, off = wgid / NXCD; wgid = (xcd < r ? xcd * (q + 1) : r * (q + 1) + (xcd - r) * q) + off; }
        const int nig = WGM * nN, gid = wgid / nig, fm = gid * WGM, gsz = (nM - fm) < WGM ? (nM - fm) : WGM;
        u.pm = fm + ((wgid % nig) % gsz); u.pn = (wgid % nig) / gsz; return true;
    }
    __device__ __forceinline__ void a_ready(const Unit&) const {}
    __device__ __forceinline__ void done(const Unit&) const {}
};

__device__ __forceinline__ unsigned cvt_pk_bf16(float lo, float hi) { unsigned r; asm volatile("v_cvt_pk_bf16_f32 %0, %1, %2" : "=v"(r) : "v"(lo), "v"(hi)); return r; }
typedef float f32x2 __attribute__((ext_vector_type(2)));
__device__ __forceinline__ u32x4 pack8(f32x4 a, f32x4 b) { u32x4 w; w.x = cvt_pk_bf16(a[0], a[1]); w.y = cvt_pk_bf16(a[2], a[3]); w.z = cvt_pk_bf16(b[0], b[1]); w.w = cvt_pk_bf16(b[2], b[3]); return w; }
__device__ __forceinline__ f32x4 shx16(f32x4 v) { f32x4 r; r[0] = __shfl_xor(v[0], 16); r[1] = __shfl_xor(v[1], 16); r[2] = __shfl_xor(v[2], 16); r[3] = __shfl_xor(v[3], 16); return r; }
__device__ __forceinline__ f32x4 silu4(f32x4 v) { return (f32x4){silu_f(v[0]), silu_f(v[1]), silu_f(v[2]), silu_f(v[3])}; }
__device__ __forceinline__ float dot4(f32x4 a) { return (a[0] * a[0] + a[1] * a[1]) + (a[2] * a[2] + a[3] * a[3]); }
struct EpiA1 {
    static constexpr bool PERM = true, AFTER_DRAIN = false, KHOOK = false;
    bf16_t* Q0; float* out; const float* ropeC; const float* ropeS;
    __device__ __forceinline__ void operator()(const f32x4 (&acc)[2][2][4][2], const Unit& u, int wr, int wc, int fr, int fq) const {
        const int sec = u.pn >> 3, col0 = (u.pn & 7) * BM + wc * 32 + 8 * fq;
        bf16_t* base = Q0 + (size_t)sec * (ACT / 2);
        const bool rot = (sec <= 1) && ((wc & 1) == 0);
#pragma unroll
        for (int ai = 0; ai < 2; ++ai)
#pragma unroll
            for (int m = 0; m < 4; ++m) {
                const int row = u.pm * BM + ai * HALF + wr * 64 + m * 16 + fr, pos = row_pos(row);
                f32x4 c0 = {1.f, 1.f, 1.f, 1.f}, c1 = c0, s0 = {0.f, 0.f, 0.f, 0.f}, s1 = s0;
                if (rot && fq < 2) { c0 = *(const f32x4*)(ropeC + pos * 8); c1 = *(const f32x4*)(ropeC + pos * 8 + 4); s0 = *(const f32x4*)(ropeS + pos * 8); s1 = *(const f32x4*)(ropeS + pos * 8 + 4); }
                float* fo = nullptr;
                if (sec == 1) fo = row < MP ? out + OUT_K_P + (size_t)row * DM : out + OUT_K_S + (size_t)(row - MP) * DM;
                else if (sec == 2) fo = row < MP ? out + OUT_V_P + (size_t)row * DM : out + OUT_V_S + (size_t)(row - MP) * DM;
#pragma unroll
                for (int bj = 0; bj < 2; ++bj) { f32x4 v0 = acc[ai][bj][m][0], v1 = acc[ai][bj][m][1]; const int col = col0 + bj * HALF;
                    if (rot) { const f32x4 p0 = shx16(v0), p1 = shx16(v1);
                        if (fq == 0) { v0 = v0 * c0 - p0 * s0; v1 = v1 * c1 - p1 * s1; } else if (fq == 1) { v0 = p0 * s0 + v0 * c0; v1 = p1 * s1 + v1 * c1; } }
                    if (sec == 0) { v0 = v0 * QSCALE; v1 = v1 * QSCALE; } else if (sec == 3) { v0 = silu4(v0); v1 = silu4(v1); }
                    if (fo) { *(f32x4*)(fo + col) = v0; *(f32x4*)(fo + col + 4) = v1; }
                    *(u32x4*)(base + (size_t)row * DM + col) = pack8(v0, v1); }
            }
    }
};
struct EpiA2 {
    static constexpr bool PERM = true, AFTER_DRAIN = false, KHOOK = false;
    const float *xp, *xs; float* out; bf16_t* xb; float* ssq;
    __device__ __forceinline__ void operator()(const f32x4 (&acc)[2][2][4][2], const Unit& u, int wr, int wc, int fr, int fq) const {
        const int col0 = u.pn * BM + wc * 32 + 8 * fq;
#pragma unroll
        for (int ai = 0; ai < 2; ++ai)
#pragma unroll
            for (int m = 0; m < 4; ++m) {
                const int row = u.pm * BM + ai * HALF + wr * 64 + m * 16 + fr;
                const float* xi = row < MP ? xp + (size_t)row * DM : xs + (size_t)(row - MP) * DM;
                float* xo = row < MP ? out + OUT_Y_P + (size_t)row * DM : out + OUT_Y_S + (size_t)(row - MP) * DM;
                float q = 0.f;
#pragma unroll
                for (int bj = 0; bj < 2; ++bj) { const int col = col0 + bj * HALF;
                    const f32x4 a0 = *(const f32x4*)(xi + col) + acc[ai][bj][m][0], a1 = *(const f32x4*)(xi + col + 4) + acc[ai][bj][m][1];
                    *(f32x4*)(xo + col) = a0; *(f32x4*)(xo + col + 4) = a1; *(u32x4*)(xb + (size_t)row * DM + col) = pack8(a0, a1); q += dot4(a0) + dot4(a1); }
                q += __shfl_xor(q, 16); q += __shfl_xor(q, 32);
                if (fq == 0) unsafeAtomicAdd(ssq + row, q);
                if (m & 1) asm volatile("" ::: "memory");
            }
    }
};
struct EpiB1 {
    static constexpr bool PERM = true, AFTER_DRAIN = false, KHOOK = false;
    bf16_t *q, *k, *v, *g; const float* ssq; const float *xc, *xs;
    __device__ __forceinline__ void operator()(const f32x4 (&acc)[2][2][4][2], const Unit& u, int wr, int wc, int fr, int fq) const {
        const int pn = u.pn, c0 = wc * 32 + 8 * fq;
#pragma unroll
        for (int ai = 0; ai < 2; ++ai)
#pragma unroll
            for (int m = 0; m < 4; ++m) {
                const int row = u.pm * BM + ai * HALF + wr * 64 + m * 16 + fr, pos = row_pos(row);
                const float r = 1.0f / sqrtf(ssq[row] * (1.f / DM) + NORM_EPS);
                if (pn < 16) {
                    bf16_t* dst = (pn < 8 ? q : k) + (size_t)row * DM + (pn & 7) * 256 + c0; const float ks = (pn < 8 ? 1.0f : 0.0625f) * r;
                    f32x4 o1[2], o2[2];
#pragma unroll
                    for (int n = 0; n < 2; ++n) { const f32x4 c = *(const f32x4*)(xc + pos * 128 + c0 + 4 * n), s = *(const f32x4*)(xs + pos * 128 + c0 + 4 * n);
                        const f32x4 x1 = acc[ai][0][m][n] * ks, x2 = acc[ai][1][m][n] * ks; o1[n] = x1 * c - x2 * s; o2[n] = x1 * s + x2 * c; }
                    *(u32x4*)dst = pack8(o1[0], o1[1]); *(u32x4*)(dst + HALF) = pack8(o2[0], o2[1]);
                } else {
                    const bool isg = pn >= 32; bf16_t* dst = (isg ? g : v) + (size_t)row * BV + (pn - (isg ? 32 : 16)) * 256 + c0;
#pragma unroll
                    for (int bj = 0; bj < 2; ++bj) { f32x4 v0 = acc[ai][bj][m][0] * r, v1 = acc[ai][bj][m][1] * r; if (isg) { v0 = silu4(v0); v1 = silu4(v1); }
                        *(u32x4*)(dst + bj * HALF) = pack8(v0, v1); }
                }
            }
    }
};
struct EpiB2 {
    static constexpr bool PERM = true, AFTER_DRAIN = false, KHOOK = true;
    float* out; const float* ssqR;
    __device__ __forceinline__ void khook(f32x4 (&acc)[2][2][4][2], const Unit& u, int h, int wr, int fr) const {
        typedef float f32x2 __attribute__((ext_vector_type(2)));
        __builtin_amdgcn_sched_barrier(0);
        int z_ = 0; asm volatile("v_mov_b32 %0, 0" : "=v"(z_));
        const int fr_ = (int)__builtin_amdgcn_mbcnt_hi(~0u, __builtin_amdgcn_mbcnt_lo(~0u, (unsigned)z_)) & 15;
        const float* qb = ssqR + (size_t)(u.pm * BM + wr * 64 + fr_) * 16 + h * 2;
#pragma unroll
        for (int ai = 0; ai < 2; ++ai)
#pragma unroll
            for (int m = 0; m < 4; ++m) {
                const float* q = qb + (ai * HALF + m * 16) * 16;
                const f32x2 cur = *(const f32x2*)q, prv = *(const f32x2*)(q - 2);
                const float f = sqrtf(((cur.x + cur.y) * (1.f / 512.f) + NORM_EPS) / ((prv.x + prv.y) * (1.f / 512.f) + NORM_EPS));
#pragma unroll
                for (int bj = 0; bj < 2; ++bj)
#pragma unroll
                    for (int n = 0; n < 2; ++n) acc[ai][bj][m][n] *= f;
                asm volatile("" : "+v"(acc[ai][0][m][0]), "+v"(acc[ai][0][m][1]), "+v"(acc[ai][1][m][0]), "+v"(acc[ai][1][m][1]) :: "memory");
            }
        __builtin_amdgcn_sched_barrier(0);
    }
    __device__ __forceinline__ void operator()(const f32x4 (&acc)[2][2][4][2], const Unit& u, int wr, int wc, int fr, int fq) const {
        const int col0 = u.pn * BM + wc * 32 + 8 * fq;
#pragma unroll
        for (int ai = 0; ai < 2; ++ai)
#pragma unroll
            for (int m = 0; m < 4; ++m) {
                const int row = u.pm * BM + ai * HALF + wr * 64 + m * 16 + fr; const float* q = ssqR + (size_t)row * 16 + 14;
                const float r7 = 1.0f / sqrtf((q[0] + q[1]) * (1.f / 512.f) + NORM_EPS);
                float* xo = row < MP ? out + OUT_Y_P + (size_t)row * DM : out + OUT_Y_S + (size_t)(row - MP) * DM;
#pragma unroll
                for (int bj = 0; bj < 2; ++bj) { const int col = col0 + bj * HALF;
                    *(f32x4*)(xo + col) = *(const f32x4*)(xo + col) + acc[ai][bj][m][0] * r7; *(f32x4*)(xo + col + 4) = *(const f32x4*)(xo + col + 4) + acc[ai][bj][m][1] * r7; }
                if (m & 1) asm volatile("" ::: "memory");
            }
    }
};
template <class Epi, class Sched, bool ALIGN_EPI = false, bool SP2 = false>
__device__ __forceinline__ void gemm_phase(PG8_LAS unsigned char* lds, const Gemm g, const Sched& S, const Epi& E) {
    const int tid = threadIdx.x, wid = __builtin_amdgcn_readfirstlane(tid >> 6), lane = tid & 63, wr = wid >> 2, wc = wid & 3, fr = lane & 15, fq = lane >> 4;
    const int K = g.K, nt = K / BK;
    unsigned voffA[2], voffB[2];
#pragma unroll
    for (int i = 0; i < 2; ++i) { int R, C; stage_rc(tid * 16 + i * 8192, R, C); const int Rb = Epi::PERM ? ((R & ~31) + perm32(R & 31)) : R;
        voffA[i] = (unsigned)(R * K + C) * 2u; voffB[i] = (unsigned)(Rb * K + C) * 2u; }
    const size_t kstep = (size_t)(BK * 2);
    const size_t hstep = (size_t)HALF * K * 2;
    const size_t tstep = 2 * hstep;
    const unsigned ldsw = (unsigned)wid * 1024u;
    const int aoff = lds_byte(wr * 64 + fr, fq * 8), boff = lds_byte(wc * 32 + fr, fq * 8);
#define PG8_SA(b, h) (((b) * 2 + (h)) * HTB)
#define PG8_SB(b, h) ((4 + (b) * 2 + (h)) * HTB)
#define PG8_STAGE(bufoff, gbase, voff) do { _Pragma("unroll") for (int _i = 0; _i < 2; ++_i) \
        __builtin_amdgcn_global_load_lds((const unsigned*)((const char*)(gbase) + (voff)[_i]), (PG8_LAS unsigned*)(lds + (bufoff) + ldsw + _i * 8192), 16, 0, 0); } while (0)
#define PG8_LDA(dst, b, h) do { _Pragma("unroll") for (int m = 0; m < 4; ++m) _Pragma("unroll") for (int k = 0; k < 2; ++k) dst[m][k] = *(const PG8_LAS bf16x8*)(lds + PG8_SA(b, h) + aoff + m * 2048 + k * 1024); } while (0)
#define PG8_LDB(dst, b, h) do { _Pragma("unroll") for (int n = 0; n < 2; ++n) _Pragma("unroll") for (int k = 0; k < 2; ++k) dst[n][k] = *(const PG8_LAS bf16x8*)(lds + PG8_SB(b, h) + boff + n * 2048 + k * 1024); } while (0)
#define PG8_MMA(ai, bj, At, Bt) do { __builtin_amdgcn_s_setprio(1); _Pragma("unroll") for (int m = 0; m < 4; ++m) _Pragma("unroll") for (int n = 0; n < 2; ++n) _Pragma("unroll") for (int k = 0; k < 2; ++k) \
        acc[ai][bj][m][n] = __builtin_amdgcn_mfma_f32_16x16x32_bf16(Bt[n][k], At[m][k], acc[ai][bj][m][n], 0, 0, 0); __builtin_amdgcn_s_setprio(0); } while (0)
#define PG8_WAIT_V(n) asm volatile("s_waitcnt vmcnt(" #n ")" ::: "memory")
#define PG8_WAIT_L(n) asm volatile("s_waitcnt lgkmcnt(" #n ")" ::: "memory")
#define PG8_BAR __builtin_amdgcn_s_barrier()
#define PG8_SCHED __builtin_amdgcn_sched_barrier(0)
    Unit cur, nxt; int ui = 0;
    if (!S.next(0, cur)) return;
    f32x4 acc[2][2][4][2];
#pragma unroll
    for (int a = 0; a < 2; ++a)
#pragma unroll
        for (int b = 0; b < 2; ++b)
#pragma unroll
            for (int m = 0; m < 4; ++m)
#pragma unroll
                for (int n = 0; n < 2; ++n) acc[a][b][m][n] = (f32x4){0.f, 0.f, 0.f, 0.f};
    bf16x8 At[4][2], B0[2][2], B1[2][2];
    const char* cA = (const char*)g.A + (size_t)cur.pm * tstep; const char* cB = (const char*)g.Bt + (size_t)cur.pn * tstep;
    S.a_ready(cur);
    if constexpr (SP2) {
        PG8_STAGE(PG8_SB(0, 0), cB, voffB); PG8_STAGE(PG8_SB(0, 1), cB + hstep, voffB); PG8_STAGE(PG8_SA(0, 0), cA, voffA); PG8_STAGE(PG8_SA(0, 1), cA + hstep, voffA);
        if (wr == 1) PG8_BAR;
        PG8_WAIT_V(2); PG8_BAR;
        PG8_STAGE(PG8_SB(1, 0), cB + kstep, voffB); PG8_STAGE(PG8_SA(1, 0), cA + kstep, voffA); PG8_STAGE(PG8_SB(1, 1), cB + hstep + kstep, voffB);
        PG8_WAIT_V(6); PG8_BAR;
    } else {
        PG8_STAGE(PG8_SB(0, 0), cB, voffB); PG8_STAGE(PG8_SA(0, 0), cA, voffA); PG8_STAGE(PG8_SB(0, 1), cB + hstep, voffB); PG8_STAGE(PG8_SA(0, 1), cA + hstep, voffA);
        if (wr == 1) PG8_BAR;
        PG8_WAIT_V(4); PG8_BAR;
        PG8_STAGE(PG8_SB(1, 0), cB + kstep, voffB); PG8_STAGE(PG8_SA(1, 0), cA + kstep, voffA); PG8_STAGE(PG8_SB(1, 1), cB + hstep + kstep, voffB);
        PG8_WAIT_V(6); PG8_BAR;
    }
    for (;;) {
        const bool has_next = S.next(ui + 1, nxt);
        const char* nA = has_next ? (const char*)g.A + (size_t)nxt.pm * tstep : cA; const char* nB = has_next ? (const char*)g.Bt + (size_t)nxt.pn * tstep : cB;
        for (int t = 0; t < nt; t += 2) {
            const bool last = (t == nt - 2);
            if constexpr (Epi::KHOOK) { if ((t & 7) == 0 && t != 0) E.khook(acc, cur, t >> 3, wr, fr); }
            const char* a1 = cA + (size_t)(t + 1) * kstep;
            const char* a2 = last ? nA : cA + (size_t)(t + 2) * kstep; const char* b2 = last ? nB : cB + (size_t)(t + 2) * kstep;
            const char* a3 = a2 + kstep; const char* b3 = b2 + kstep;
            if (last && has_next) S.a_ready(nxt);
            if constexpr (SP2) {
            PG8_LDB(B0, 0, 0); PG8_LDB(B1, 0, 1); PG8_SCHED; PG8_LDA(At, 0, 0); PG8_STAGE(PG8_SA(1, 1), a1 + hstep, voffA);
            PG8_WAIT_V(8); PG8_WAIT_L(0); PG8_BAR; PG8_MMA(0, 0, At, B0); PG8_MMA(0, 1, At, B1); PG8_BAR; PG8_SCHED;
            PG8_LDA(At, 0, 1); PG8_STAGE(PG8_SB(0, 0), b2, voffB); PG8_STAGE(PG8_SB(0, 1), b2 + hstep, voffB); PG8_STAGE(PG8_SA(0, 0), a2, voffA);
            PG8_WAIT_V(8); PG8_WAIT_L(0); PG8_BAR; PG8_MMA(1, 0, At, B0); PG8_MMA(1, 1, At, B1); PG8_BAR; PG8_SCHED;
            PG8_LDB(B0, 1, 0); PG8_LDB(B1, 1, 1); PG8_SCHED; PG8_LDA(At, 1, 0); PG8_STAGE(PG8_SA(0, 1), a2 + hstep, voffA);
            PG8_WAIT_V(8); PG8_WAIT_L(0); PG8_BAR; PG8_MMA(0, 0, At, B0); PG8_MMA(0, 1, At, B1); PG8_BAR; PG8_SCHED;
            PG8_LDA(At, 1, 1); PG8_STAGE(PG8_SB(1, 0), b3, voffB); PG8_STAGE(PG8_SB(1, 1), b3 + hstep, voffB); PG8_STAGE(PG8_SA(1, 0), a3, voffA);
            PG8_WAIT_V(8); PG8_WAIT_L(0); PG8_BAR; PG8_MMA(1, 0, At, B0); PG8_MMA(1, 1, At, B1); PG8_BAR; PG8_SCHED;
            } else {
            PG8_LDB(B0, 0, 0); PG8_SCHED; PG8_LDA(At, 0, 0); PG8_STAGE(PG8_SA(1, 1), a1 + hstep, voffA);
            PG8_WAIT_L(8); PG8_BAR; PG8_WAIT_L(0); PG8_MMA(0, 0, At, B0); PG8_BAR; PG8_SCHED;
            PG8_LDB(B1, 0, 1); PG8_STAGE(PG8_SB(0, 0), b2, voffB);
            PG8_BAR; PG8_WAIT_L(0); PG8_MMA(0, 1, At, B1); PG8_BAR;
            PG8_LDA(At, 0, 1); PG8_STAGE(PG8_SA(0, 0), a2, voffA);
            PG8_BAR; PG8_WAIT_L(0); PG8_MMA(1, 0, At, B0); PG8_BAR; PG8_SCHED;
            PG8_STAGE(PG8_SB(0, 1), b2 + hstep, voffB);
            PG8_WAIT_V(6); PG8_BAR; PG8_MMA(1, 1, At, B1); PG8_BAR;
            PG8_LDB(B0, 1, 0); PG8_SCHED; PG8_LDA(At, 1, 0); PG8_STAGE(PG8_SA(0, 1), a2 + hstep, voffA);
            PG8_WAIT_L(8); PG8_BAR; PG8_WAIT_L(0); PG8_MMA(0, 0, At, B0); PG8_BAR; PG8_SCHED;
            PG8_LDB(B1, 1, 1); PG8_STAGE(PG8_SB(1, 0), b3, voffB);
            PG8_BAR; PG8_WAIT_L(0); PG8_MMA(0, 1, At, B1); PG8_BAR;
            PG8_LDA(At, 1, 1); PG8_STAGE(PG8_SA(1, 0), a3, voffA);
            PG8_BAR; PG8_WAIT_L(0); PG8_MMA(1, 0, At, B0); PG8_BAR; PG8_SCHED;
            PG8_STAGE(PG8_SB(1, 1), b3 + hstep, voffB);
            PG8_WAIT_V(6); PG8_BAR; PG8_MMA(1, 1, At, B1); PG8_BAR;
            }
        }
        if constexpr (ALIGN_EPI) { if (wr == 0) PG8_BAR; }
        if constexpr (!Epi::AFTER_DRAIN) { E(acc, cur, wr, wc, fr, fq); S.done(cur); }
        if (!has_next) break;
#pragma unroll
        for (int a = 0; a < 2; ++a)
#pragma unroll
            for (int b = 0; b < 2; ++b)
#pragma unroll
                for (int m = 0; m < 4; ++m)
#pragma unroll
                    for (int n = 0; n < 2; ++n) acc[a][b][m][n] = (f32x4){0.f, 0.f, 0.f, 0.f};
        cur = nxt; cA = nA; cB = nB; ++ui;
        if constexpr (ALIGN_EPI) { if (wr == 1) PG8_BAR; }
    }
    PG8_WAIT_V(0);
    if constexpr (!ALIGN_EPI) { if (wr == 0) PG8_BAR; }
    PG8_BAR;
    if constexpr (Epi::AFTER_DRAIN) { E.fused(acc, cur, wr, wc, fr, fq, lds, wid, lane); S.done(cur); }
#undef PG8_SA
#undef PG8_SB
#undef PG8_STAGE
#undef PG8_LDA
#undef PG8_LDB
#undef PG8_MMA
#undef PG8_WAIT_V
#undef PG8_WAIT_L
#undef PG8_BAR
#undef PG8_SCHED
}
}
namespace att {
typedef short v4i16_t __attribute__((ext_vector_type(4)));
constexpr int KV_BUF = 32768, V_OFF = 16384, XCH_OFF = 65536, STG_PITCH = 272;
__device__ __forceinline__ bf16x8 ldsK(const LAS unsigned char* kb, int row, int chunk) { return *(const LAS bf16x8*)(kb + row * 128 + ((chunk ^ ((row >> 1) & 7)) << 4)); }
__device__ __forceinline__ unsigned cvtpk(float lo, float hi) { typedef float f2 __attribute__((ext_vector_type(2))); typedef __bf16 b2 __attribute__((ext_vector_type(2))); f2 v = {lo, hi}; b2 b = __builtin_convertvector(v, b2); return __builtin_bit_cast(unsigned, b); }
__device__ __forceinline__ u32x4 cvt8(f32x4 a, f32x4 b) { u32x4 w; w.x = cvtpk(a[0], a[1]); w.y = cvtpk(a[2], a[3]); w.z = cvtpk(b[0], b[1]); w.w = cvtpk(b[2], b[3]); return w; }

struct State { f32x16 o[4]; float m, l; };

template <bool TAIL16>
__device__ __forceinline__ void tile_step(State& st, const LAS unsigned char* kb, const LAS unsigned char* vb, const bf16x8 (&qf)[4]) {
    const int lane = fresh_lane(), r32 = lane & 31, hi = lane >> 5;
    const LAS unsigned char* ka[4];
#pragma unroll
    for (int ks = 0; ks < 4; ++ks) ka[ks] = kb + r32 * 128 + (((2 * ks + hi) ^ ((r32 >> 1) & 7)) << 4);
    f32x16 p[2];
#pragma unroll
    for (int blk = 0; blk < 2; ++blk) {
        p[blk] = (f32x16){0.f, 0.f, 0.f, 0.f, 0.f, 0.f, 0.f, 0.f, 0.f, 0.f, 0.f, 0.f, 0.f, 0.f, 0.f, 0.f};
#pragma unroll
        for (int ks = 0; ks < 4; ++ks) p[blk] = __builtin_amdgcn_mfma_f32_32x32x16_bf16(*(const LAS bf16x8*)(ka[ks] + blk * 4096), qf[ks], p[blk], 0, 0, 0);
    }
    if (TAIL16) {
#pragma unroll
        for (int i = 8; i < 16; ++i) p[0][i] = -1e30f;
#pragma unroll
        for (int i = 0; i < 16; ++i) p[1][i] = -1e30f;
    }
    float mt = p[0][0];
#pragma unroll
    for (int i = 1; i < 16; ++i) mt = fmaxf(mt, p[0][i]);
#pragma unroll
    for (int i = 0; i < 16; ++i) mt = fmaxf(mt, p[1][i]);
    mt = fmaxf(mt, __shfl_xor(mt, 32));
    const float mn = fmaxf(st.m, mt);
    if (__any(mn > st.m)) {
        const float alpha = __builtin_amdgcn_exp2f(st.m - mn); st.l *= alpha;
#pragma unroll
        for (int c = 0; c < 4; ++c)
#pragma unroll
            for (int i = 0; i < 16; ++i) st.o[c][i] *= alpha;
        st.m = mn;
    }
    float ls = 0.f;
#pragma unroll
    for (int blk = 0; blk < 2; ++blk)
#pragma unroll
        for (int i = 0; i < 16; ++i) { p[blk][i] = __builtin_amdgcn_exp2f(p[blk][i] - st.m); ls += p[blk][i]; }
    st.l += ls;
    bf16x8 pb[4];
#pragma unroll
    for (int kk = 0; kk < 4; ++kk) { const int blk = kk >> 1, s2 = kk & 1; u32x4 w;
        w.x = cvtpk(p[blk][8 * s2 + 0], p[blk][8 * s2 + 1]); w.y = cvtpk(p[blk][8 * s2 + 2], p[blk][8 * s2 + 3]); w.z = cvtpk(p[blk][8 * s2 + 4], p[blk][8 * s2 + 5]); w.w = cvtpk(p[blk][8 * s2 + 6], p[blk][8 * s2 + 7]);
        pb[kk] = __builtin_bit_cast(bf16x8, w); }
    const int q4 = (lane & 15) >> 2, pp = lane & 3, blkv = (lane >> 4) & 1;
    const LAS unsigned char* va[4];
#pragma unroll
    for (int c = 0; c < 4; ++c) va[c] = vb + (4 * hi + q4) * 256 + (((4 * c + 2 * blkv + (pp >> 1)) ^ (q4 << 2)) << 4) + ((pp & 1) << 3);
#pragma unroll
    for (int kk = 0; kk < (TAIL16 ? 1 : 4); ++kk) {
#pragma unroll
        for (int c = 0; c < 4; ++c) {
            const v4i16_t lo = __builtin_amdgcn_ds_read_tr16_b64_v4i16((LAS v4i16_t*)(va[c] + (16 * kk) * 256));
            const v4i16_t hh = __builtin_amdgcn_ds_read_tr16_b64_v4i16((LAS v4i16_t*)(va[c] + (16 * kk + 8) * 256));
            const bf16x8 vf = {lo[0], lo[1], lo[2], lo[3], hh[0], hh[1], hh[2], hh[3]};
            st.o[c] = __builtin_amdgcn_mfma_f32_32x32x16_bf16(vf, pb[kk], st.o[c], 0, 0, 0);
        }
    }
}

struct Stage { u32x4 k[2], v[2]; };
__device__ __forceinline__ void stage_store(LAS unsigned char* buf, const Stage& s, int wave) {
    const int tid = wave * 64 + fresh_lane();
#pragma unroll
    for (int i = 0; i < 2; ++i) { const int id = tid + 512 * i, r = id >> 4, c16 = id & 15;
        *(LAS u32x4*)(buf + (c16 >> 3) * 8192 + r * 128 + (((c16 & 7) ^ ((r >> 1) & 7)) << 4)) = s.k[i];
        *(LAS u32x4*)(buf + V_OFF + r * 256 + ((c16 ^ ((r & 3) << 2)) << 4)) = s.v[i]; }
}
__device__ __forceinline__ void stage_load_bf16(Stage& s, const bf16_t* K, const bf16_t* V, size_t row0, int h, int wave, int nvalid) {
    const int tid = wave * 64 + fresh_lane();
#pragma unroll
    for (int i = 0; i < 2; ++i) { const int id = tid + 512 * i, r = id >> 4, c16 = id & 15; const size_t off = (row0 + r) * DM + h * 128 + c16 * 8;
        if (r < nvalid) { s.k[i] = *(const u32x4*)(K + off); s.v[i] = *(const u32x4*)(V + off); } else { s.k[i] = (u32x4){0u, 0u, 0u, 0u}; s.v[i] = (u32x4){0u, 0u, 0u, 0u}; } }
}
struct StageF { f32x4 k[2][2], v[2][2]; };
__device__ __forceinline__ void stage_load_f32(StageF& s, const float* K, const float* V, size_t row0, int h, int wave) {
    const int tid = wave * 64 + fresh_lane();
#pragma unroll
    for (int i = 0; i < 2; ++i) { const int id = tid + 512 * i, r = id >> 4, c16 = id & 15; const size_t off = (row0 + r) * DM + h * 128 + c16 * 8;
        s.k[i][0] = *(const f32x4*)(K + off); s.k[i][1] = *(const f32x4*)(K + off + 4); s.v[i][0] = *(const f32x4*)(V + off); s.v[i][1] = *(const f32x4*)(V + off + 4); }
}
__device__ __forceinline__ void stage_cvt(Stage& d, const StageF& s) {
#pragma unroll
    for (int i = 0; i < 2; ++i) { d.k[i] = cvt8(s.k[i][0], s.k[i][1]); d.v[i] = cvt8(s.v[i][0], s.v[i][1]); }
}

__device__ __forceinline__ void unit_epilogue(State& st, LAS unsigned char* L, const Ptrs& P, size_t urow0, int h, int nrows, float lam, int wave) {
    const int lane = fresh_lane(), tid = wave * 64 + lane, rg = wave >> 1, s = wave & 1, r32 = lane & 31, hi = lane >> 5;
    const float lt = st.l + __shfl_xor(st.l, 32); const float inv = 1.0f / lt;
    LAS float* xch = (LAS float*)(L + XCH_OFF) + rg * 4096;
    if (s == 1) {
        const float f = inv * lam;
#pragma unroll
        for (int c = 0; c < 4; ++c)
#pragma unroll
            for (int i = 0; i < 16; ++i) xch[(c * 16 + i) * 64 + lane] = st.o[c][i] * f;
    }
    __syncthreads();
    if (s == 0) {
        float ssq = 0.f;
#pragma unroll
        for (int c = 0; c < 4; ++c)
#pragma unroll
            for (int i = 0; i < 16; ++i) { const float d = st.o[c][i] * inv - xch[(c * 16 + i) * 64 + lane]; st.o[c][i] = d; ssq += d * d; }
        ssq += __shfl_xor(ssq, 32);
        const float r = (1.0f - LAMBDA_INIT) / sqrtf(ssq * (1.f / 128.f) + SUBLN_EPS);
        LAS unsigned char* stg = L + (rg * 32 + r32) * STG_PITCH;
#pragma unroll
        for (int c = 0; c < 4; ++c)
#pragma unroll
            for (int g = 0; g < 4; ++g) { const int dv = 32 * c + 8 * g + 4 * hi; const f32x4 w = *(const f32x4*)(P.subln + dv);
                u32x2 o; o.x = cvtpk(st.o[c][4 * g] * r * w[0], st.o[c][4 * g + 1] * r * w[1]); o.y = cvtpk(st.o[c][4 * g + 2] * r * w[2], st.o[c][4 * g + 3] * r * w[3]);
                *(LAS u32x2*)(stg + dv * 2) = o; }
    }
    __syncthreads();
    const bf16_t* G0 = (const bf16_t*)(P.ws + WS_G0); bf16_t* O0 = (bf16_t*)(P.ws + WS_XN0);
#pragma unroll
    for (int i = 0; i < 4; ++i) { const int id = tid + 512 * i, row = id >> 4, ch = id & 15;
        if (row < nrows) { const u32x4 v = *(const LAS u32x4*)(L + row * STG_PITCH + ch * 16); const size_t off = (urow0 + row) * DM + h * 128 + ch * 8; const u32x4 g = *(const u32x4*)(G0 + off);
            u32x4 o;
#pragma unroll
            for (int j = 0; j < 4; ++j) { const float a0 = __builtin_bit_cast(float, v[j] << 16) * __builtin_bit_cast(float, g[j] << 16), a1 = __builtin_bit_cast(float, v[j] & 0xffff0000u) * __builtin_bit_cast(float, g[j] & 0xffff0000u); o[j] = cvtpk(a0, a1); }
            *(u32x4*)(O0 + off) = o; } }
    __syncthreads();
}

__device__ __forceinline__ void attn_phase(const Ptrs& P, unsigned char* lds, int vcu, int G) {
    LAS unsigned char* L = (LAS unsigned char*)lds;
    const int tid = threadIdx.x, lane = tid & 63, wave = __builtin_amdgcn_readfirstlane(tid >> 6), rg = wave >> 1, s = wave & 1, r32 = lane & 31, hi = lane >> 5;
    const bf16_t* Q0 = (const bf16_t*)(P.ws + WS_Q0); const bf16_t* K0 = (const bf16_t*)(P.ws + WS_K0); const bf16_t* V0 = (const bf16_t*)(P.ws + WS_V0);
    const float lam = *(const float*)(P.ws + WS_LAM);
    for (int bh = vcu; bh < NB * 16; bh += G) {
        const int b = bh >> 4, h = bh & 15;
        for (int qb = 15; qb >= 0; --qb) {
            const size_t urow0 = (size_t)b * SEQ + qb * 128, qrow = urow0 + rg * 32 + r32;
            bf16x8 qf[4];
#pragma unroll
            for (int ks = 0; ks < 4; ++ks) qf[ks] = *(const bf16x8*)(Q0 + qrow * DM + h * 128 + s * 64 + ks * 16 + hi * 8);
            State st; st.m = -1e30f; st.l = 0.f;
#pragma unroll
            for (int c = 0; c < 4; ++c) st.o[c] = (f32x16){0.f, 0.f, 0.f, 0.f, 0.f, 0.f, 0.f, 0.f, 0.f, 0.f, 0.f, 0.f, 0.f, 0.f, 0.f, 0.f};
            const int NT = 2 * qb + 2, NTW = 2 * qb + 1 + (rg >> 1);
            Stage sg; stage_load_bf16(sg, K0, V0, (size_t)b * SEQ, h, wave, 64); stage_store(L, sg, wave); __syncthreads();
            for (int t = 0; t < NT; ++t) {
                if (t + 1 < NT) stage_load_bf16(sg, K0, V0, (size_t)b * SEQ + (size_t)(t + 1) * 64, h, wave, 64);
                const LAS unsigned char* buf = L + (t & 1) * KV_BUF;
                if (t < NTW) tile_step<false>(st, buf + s * 8192, buf + V_OFF, qf);
                if (t + 1 < NT) stage_store(L + ((t + 1) & 1) * KV_BUF, sg, wave);
                __syncthreads();
            }
            unit_epilogue(st, L, P, urow0, h, 128, lam, wave);
        }
        {
            const size_t urow0 = (size_t)MP + b * DSEQ, qrow = urow0 + (r32 & 15);
            bf16x8 qf[4];
#pragma unroll
            for (int ks = 0; ks < 4; ++ks) qf[ks] = *(const bf16x8*)(Q0 + qrow * DM + h * 128 + s * 64 + ks * 16 + hi * 8);
            State st; st.m = -1e30f; st.l = 0.f;
#pragma unroll
            for (int c = 0; c < 4; ++c) st.o[c] = (f32x16){0.f, 0.f, 0.f, 0.f, 0.f, 0.f, 0.f, 0.f, 0.f, 0.f, 0.f, 0.f, 0.f, 0.f, 0.f, 0.f};
            constexpr int NT = PAST / 64 + 1;
            Stage sg; StageF sf;
            stage_load_f32(sf, P.ck, P.cv, (size_t)b * PAST, h, wave); stage_cvt(sg, sf); stage_store(L, sg, wave); __syncthreads();
            for (int t = 0; t < NT; ++t) {
                if (t + 1 < NT - 1) stage_load_f32(sf, P.ck, P.cv, (size_t)b * PAST + (size_t)(t + 1) * 64, h, wave);
                else if (t + 1 == NT - 1) stage_load_bf16(sg, K0, V0, urow0, h, wave, DSEQ);
                const LAS unsigned char* buf = L + (t & 1) * KV_BUF;
                if (rg == 0) { if (t < NT - 1) tile_step<false>(st, buf + s * 8192, buf + V_OFF, qf); else tile_step<true>(st, buf + s * 8192, buf + V_OFF, qf); }
                if (t + 1 < NT - 1) stage_cvt(sg, sf);
                if (t + 1 < NT) stage_store(L + ((t + 1) & 1) * KV_BUF, sg, wave);
                __syncthreads();
            }
            unit_epilogue(st, L, P, urow0, h, DSEQ, lam, wave);
        }
    }
}
}
using att::attn_phase;
#ifndef HAVE_ATT
#define HAVE_ATT 0
#endif
#ifndef HAVE_RET
#define HAVE_RET 0
#endif
#ifndef PH_MASK
#define PH_MASK 0xFF
#endif
#define PH_EN(k) (((PH_MASK) >> (k)) & 1)
struct Args { Ptrs P; int ph_lo, ph_hi; };
__global__ void __launch_bounds__(NWAVES * 64, 2) mega(Args args) {
    extern __shared__ __attribute__((aligned(16))) unsigned char lds[];
    const Ptrs& P = args.P;
    const int tid = threadIdx.x, lane = tid & 63, wave = __builtin_amdgcn_readfirstlane(tid >> 6);
    const int G = gridDim.x, bx = blockIdx.x, vcu = (G % 8 == 0) ? (bx % 8) * (G / 8) + bx / 8 : bx;
    LAS unsigned char* L = (LAS unsigned char*)lds;
    volatile LAS unsigned* MISC = (volatile LAS unsigned*)(L + MISC_OFF);
    for (int u = tid; u < (LDS_BYTES - RING_BYTES) / 4; u += NWAVES * 64) ((LAS unsigned*)(L + RING_BYTES))[u] = 0u;
    __syncthreads();
    const int lo = args.ph_lo, hi = args.ph_hi;
    const bool multi = hi - lo > 1;
    XcdBarrier bar; bar.bar = (unsigned*)(P.ws + WS_CTL) + CW_BAR; bar.x = 0; bar.st = nullptr;
    if (multi) bar = xcd_barrier_post((unsigned*)(P.ws + WS_CTL) + CW_BAR, MISC + 8);
#define IN(k) (lo <= (k) && (k) < hi)
#define BOTH(k) (IN(k) && IN((k) + 1))
    const int gw = vcu * NWAVES + wave, ngw = G * NWAVES;
    unsigned char* ws = P.ws;
    bf16_t* XN0 = (bf16_t*)(ws + WS_XN0); bf16_t* Q0 = (bf16_t*)(ws + WS_Q0); bf16_t* K0 = (bf16_t*)(ws + WS_K0); bf16_t* V0 = (bf16_t*)(ws + WS_V0); bf16_t* GR = (bf16_t*)(ws + WS_GR);
    if (IN(0)) { p0_prologue(P, (LAS float*)(L + wave * 16384), gw, ngw, lane); if (BOTH(0)) xcd_barrier(bar); }
    if (PH_EN(1) && IN(1)) {
        pg8::Gemm g{XN0, (const bf16_t*)(ws + WS_WINA), MT, NA_IN, DM}; pg8::StaticOrder S; S.init(MT, NA_IN, G, bx);
        pg8::EpiA1 E{Q0, P.out, (const float*)(ws + WS_ROPE), (const float*)(ws + WS_ROPE) + 2048 * 8};
        pg8::gemm_phase<pg8::EpiA1, pg8::StaticOrder, true, true>(L, g, S, E);
        if (BOTH(1)) xcd_barrier(bar);
    }
#if HAVE_ATT
    if (IN(2)) { attn_phase(P, lds, vcu, G); if (BOTH(2)) xcd_barrier(bar); }
#endif
    if (PH_EN(3) && IN(3)) {
        pg8::Gemm g{XN0, (const bf16_t*)(ws + WS_WOUTA), MT, DM, DM}; pg8::StaticOrder S; S.init(MT, DM, G, bx);
        pg8::EpiA2 E{P.x_p, P.x_s, P.out, Q0, (float*)(ws + WS_SSQ1)};
        pg8::gemm_phase<pg8::EpiA2, pg8::StaticOrder, true, true>(L, g, S, E);
        if (BOTH(3)) xcd_barrier(bar);
    }
    if (PH_EN(4) && IN(4)) {
        pg8::Gemm g{Q0, (const bf16_t*)(ws + WS_WINB), MT, NB_IN, DM}; pg8::StaticOrder S; S.init(MT, NB_IN, G, bx);
        pg8::EpiB1 E{XN0, K0, V0, GR, (const float*)(ws + WS_SSQ1), (const float*)(ws + WS_XPOS), (const float*)(ws + WS_XPOS) + 2048 * 128};
        pg8::gemm_phase<pg8::EpiB1, pg8::StaticOrder, true, true>(L, g, S, E);
        if (BOTH(4)) xcd_barrier(bar);
    }
#if HAVE_RET
    if (IN(5)) { ret_phase(P, lds, vcu, G); if (BOTH(5)) xcd_barrier(bar); }
#endif
    if (PH_EN(6) && IN(6)) {
        pg8::Gemm g{GR, (const bf16_t*)(ws + WS_WOUTB), MT, DM, BV}; pg8::StaticOrder S; S.init(MT, DM, G, bx);
        pg8::EpiB2 E{P.out, (const float*)(ws + WS_SSQR)};
        pg8::gemm_phase<pg8::EpiB2, pg8::StaticOrder, true, true>(L, g, S, E);
        if (BOTH(6)) xcd_barrier(bar);
    }
    if (IN(7)) { p7_final(P, gw, ngw, fresh_lane()); }
#undef IN
#undef BOTH
}
#ifndef FAST_MASK
#define FAST_MASK 0
#endif
extern "C" void kernel_launch(void* const* d_in, const int* in_sizes, int n_in, void* d_out, int out_size, void* d_ws, size_t ws_size, hipStream_t stream) {
    static int grid = 0;
    if (grid == 0) {
        if (n_in != 17 || (size_t)out_size != OUT_TOTAL || ws_size < WS_END) { fprintf(stderr, "kernel_launch: unexpected sizes n_in %d out %d ws %zu (need %zu)\n", n_in, out_size, ws_size, (size_t)WS_END); grid = -1; return; }
        int dev = 0, cus = 0;
        if (hipGetDevice(&dev) != hipSuccess || hipDeviceGetAttribute(&cus, hipDeviceAttributeMultiprocessorCount, dev) != hipSuccess) { grid = -1; return; }
        if (hipFuncSetAttribute((const void*)mega, hipFuncAttributeMaxDynamicSharedMemorySize, LDS_BYTES) != hipSuccess) { fprintf(stderr, "kernel_launch: hipFuncSetAttribute failed\n"); grid = -1; return; }
        int per_cu = 0;
        if (hipOccupancyMaxActiveBlocksPerMultiprocessor(&per_cu, (const void*)mega, NWAVES * 64, LDS_BYTES) != hipSuccess || per_cu < 1) fprintf(stderr, "kernel_launch: occupancy query says %d\n", per_cu);
        (void)hipGetLastError();
        grid = cus;
    }
    if (grid < 0) return;
    Args a{};
    const float** pp = (const float**)&a.P;
    for (int i = 0; i < 17; ++i) pp[i] = (const float*)d_in[i];
    a.P.out = (float*)d_out; a.P.ws = (unsigned char*)d_ws;
    const Ptrs& P = a.P; unsigned char* ws = a.P.ws;
    hipMemsetAsync(ws + WS_CTL, 0, CTL_ZERO_BYTES, stream);
    auto run = [&](int lo, int hi) { a.ph_lo = lo; a.ph_hi = hi; hipLaunchKernelGGL(mega, dim3(grid), dim3(NWAVES * 64), LDS_BYTES, stream, a); };
#if FAST_MASK == 0xFF
    run(0, 8);
#else
    bf16_t* XN0 = (bf16_t*)(ws + WS_XN0); bf16_t* Q0 = (bf16_t*)(ws + WS_Q0); bf16_t* K0 = (bf16_t*)(ws + WS_K0); bf16_t* V0 = (bf16_t*)(ws + WS_V0); bf16_t* GR = (bf16_t*)(ws + WS_GR);
    run(0, 1);
    if (FAST_MASK & 2) run(1, 2);
    else { { orc::ERaw e{Q0, 2048, 2048, ACT / 2, nullptr}; hipLaunchKernelGGL(orc::s_gemm<orc::ERaw>, dim3(NA_IN / 64, MT / 64), dim3(256), 0, stream, XN0, (const bf16_t*)(ws + WS_WINA), DM, e); }
        hipLaunchKernelGGL(orc::s_post1, dim3((unsigned)(((size_t)MT * NA_IN + 255) / 256)), dim3(256), 0, stream, P); }
    if (FAST_MASK & 4) run(2, 3);
    else { hipLaunchKernelGGL(orc::s_attn, dim3(MP, 16), dim3(128), 0, stream, P, 0); hipLaunchKernelGGL(orc::s_attn, dim3(MS, 16), dim3(128), 0, stream, P, 1); }
    if (FAST_MASK & 8) run(3, 4);
    else { { orc::ERes1 e{P.x_p, P.x_s, P.out, Q0}; hipLaunchKernelGGL(orc::s_gemm<orc::ERes1>, dim3(DM / 64, MT / 64), dim3(256), 0, stream, XN0, (const bf16_t*)(ws + WS_WOUTA), DM, e); }
        hipLaunchKernelGGL(orc::s_rowssq, dim3(MT / 4), dim3(256), 0, stream, P); }
    if (FAST_MASK & 16) run(4, 5);
    else { { orc::ERaw3 e{XN0, K0, V0, GR, (const float*)(ws + WS_SSQ1)}; hipLaunchKernelGGL(orc::s_gemm<orc::ERaw3>, dim3(NB_IN / 64, MT / 64), dim3(256), 0, stream, Q0, (const bf16_t*)(ws + WS_WINB), DM, e); }
        hipLaunchKernelGGL(orc::s_post3, dim3((unsigned)(((size_t)MT * NB_IN + 255) / 256)), dim3(256), 0, stream, P); }
    if (FAST_MASK & 32) run(5, 6);
    else hipLaunchKernelGGL(orc::s_ret, dim3(8, 8, 32), dim3(256), 0, stream, P);
    if (FAST_MASK & 64) run(6, 7);
    else { hipLaunchKernelGGL(orc::s_norm_o1, dim3((unsigned)(((size_t)MT * BV + 255) / 256)), dim3(256), 0, stream, P);
        { orc::ERes2 e{P.out}; hipLaunchKernelGGL(orc::s_gemm<orc::ERes2>, dim3(DM / 64, MT / 64), dim3(256), 0, stream, GR, (const bf16_t*)(ws + WS_WOUTB), BV, e); } }
    run(7, 8);
#endif
}
```

```cpp
#define FAST_MASK 0xFF
#define HAVE_ATT 1
#define HAVE_RET 1
#include <hip/hip_runtime.h>
#include <cstdio>
#include <cstdint>

constexpr int DM = 2048, SEQ = 2048, NB = 16, DSEQ = 16, PAST = 1024;
constexpr int MP = NB * SEQ;
constexpr int MS = NB * DSEQ;
constexpr int MT = MP + MS;
constexpr int NA_IN = 8192, NB_IN = 12288, BV = 4096;
constexpr float QSCALE = 0.125f * 1.4426950408889634f;
constexpr float LAMBDA_INIT = 0.2f;
constexpr float NORM_EPS = 1e-6f, SUBLN_EPS = 1e-5f;

constexpr size_t OUT_Y_P = 0, OUT_Y_S = OUT_Y_P + (size_t)MP * DM, OUT_K_P = OUT_Y_S + (size_t)MS * DM, OUT_V_P = OUT_K_P + (size_t)MP * DM,
                 OUT_ST_P = OUT_V_P + (size_t)MP * DM, OUT_K_S = OUT_ST_P + (size_t)NB * 8 * 256 * 512, OUT_V_S = OUT_K_S + (size_t)MS * DM,
                 OUT_ST_S = OUT_V_S + (size_t)MS * DM, OUT_TOTAL = OUT_ST_S + (size_t)NB * 8 * 256 * 512;

constexpr size_t MiB = 1u << 20;
constexpr size_t WS_CTL = 0, CTL_ZERO_BYTES = 7 * MiB;
constexpr size_t WS_SSQ1 = 256 * 1024;
constexpr size_t WS_SSQR = 4 * MiB;
constexpr size_t WS_ROPE = 1 * MiB;
constexpr size_t WS_XPOS = 2 * MiB;
constexpr size_t WS_LAM = 7 * MiB;
constexpr size_t WS_WINA = 8 * MiB, WS_WOUTA = 40 * MiB, WS_WINB = 48 * MiB, WS_WOUTB = 96 * MiB;
constexpr size_t ACT = (size_t)MT * DM * 2;
constexpr size_t WS_XN0 = 112 * MiB;
constexpr size_t WS_Q0 = WS_XN0 + ACT;
constexpr size_t WS_K0 = WS_Q0 + ACT;
constexpr size_t WS_V0 = WS_K0 + ACT;
constexpr size_t WS_G0 = WS_V0 + ACT;
constexpr size_t WS_GR = WS_G0 + ACT;
constexpr size_t WS_END = WS_GR + 2 * ACT;
static_assert(WS_END == 1015 * MiB, "ws map");
constexpr int CW_BAR = 4096;

typedef unsigned short bf16_t;
typedef short bf16x8 __attribute__((ext_vector_type(8)));
typedef float f32x4 __attribute__((ext_vector_type(4)));
typedef float f32x16 __attribute__((ext_vector_type(16)));
typedef unsigned u32x4 __attribute__((ext_vector_type(4)));
typedef unsigned u32x2 __attribute__((ext_vector_type(2)));

__device__ __forceinline__ unsigned f2bf(float f) { unsigned u = __builtin_bit_cast(unsigned, f); return (u + 0x7fffu + ((u >> 16) & 1u)) >> 16; }
__device__ __forceinline__ float bf2f(unsigned short b) { return __builtin_bit_cast(float, (unsigned)b << 16); }
__device__ __forceinline__ unsigned pk2(float lo, float hi) { return f2bf(lo) | (f2bf(hi) << 16); }
__device__ __forceinline__ float silu_f(float x) { return x * __builtin_amdgcn_rcpf(1.0f + __builtin_amdgcn_exp2f(-1.4426950408889634f * x)); }
__device__ __forceinline__ float wave_sum(float v) {
#pragma unroll
    for (int o = 1; o < 64; o <<= 1) v += __shfl_xor(v, o);
    return v;
}
__device__ __forceinline__ int row_pos(int row) { return row < MP ? (row & (SEQ - 1)) : PAST + ((row - MP) & (DSEQ - 1)); }

struct Ptrs {
    const float *x_p, *x_s, *ck, *cv, *st, *norm_a, *w_in_a, *lq1, *lk1, *lq2, *lk2, *subln, *w_out_a, *norm_b, *w_in_b, *w_out_b, *norm_f;
    float* out; unsigned char* ws;
};
#define LAS __attribute__((address_space(3)))
#define GAS __attribute__((address_space(1)))
__device__ __forceinline__ void p0_transpose_item(const float* W, const float* gain, int K, int N, bf16_t* WT, LAS float* scr, int item, int lane) {
    const int nblk = N / 32, kb = item / nblk, nb = item % nblk, k0 = 64 * kb, n0 = 32 * nb;
#pragma unroll 8
    for (int i = 0; i < 32; ++i) { const int kk = 2 * i + (lane >> 5); float w = W[(size_t)(k0 + kk) * N + n0 + (lane & 31)]; if (gain) w *= gain[k0 + kk]; scr[kk * 33 + (lane & 31)] = w; }
    asm volatile("s_waitcnt lgkmcnt(0)" ::: "memory");
    const int c = lane & 7;
#pragma unroll
    for (int j = 0; j < 4; ++j) { const int n = (lane >> 3) + 8 * j; const LAS float* s = scr + (8 * c) * 33 + n;
        u32x4 o; o.x = pk2(s[0 * 33], s[1 * 33]); o.y = pk2(s[2 * 33], s[3 * 33]); o.z = pk2(s[4 * 33], s[5 * 33]); o.w = pk2(s[6 * 33], s[7 * 33]);
        *(u32x4*)(WT + (size_t)(n0 + n) * K + k0 + 8 * c) = o; }
    asm volatile("s_waitcnt lgkmcnt(0)" ::: "memory");
}
__device__ __forceinline__ void p0_norm_row(const float* xrow, const float* g, bf16_t* orow, int lane) {
    const f32x4* xr = (const f32x4*)xrow + lane; const f32x4* gr = (const f32x4*)g + lane;
    f32x4 v[8]; float s = 0.f;
#pragma unroll
    for (int j = 0; j < 8; ++j) { v[j] = xr[64 * j]; s += (v[j].x * v[j].x + v[j].y * v[j].y) + (v[j].z * v[j].z + v[j].w * v[j].w); }
    const float r = 1.0f / sqrtf(wave_sum(s) * (1.f / DM) + NORM_EPS);
    u32x2* o8 = (u32x2*)orow + lane;
#pragma unroll
    for (int j = 0; j < 8; ++j) { const f32x4 gg = gr[64 * j]; u32x2 w; w.x = pk2(v[j].x * r * gg.x, v[j].y * r * gg.y); w.y = pk2(v[j].z * r * gg.z, v[j].w * r * gg.w); o8[64 * j] = w; }
}
__device__ __forceinline__ void sincos_rev(float angle, float& c, float& s) {
    const double rev = (double)angle * 0.15915494309189533577; const float fr = (float)(rev - __builtin_rint(rev));
    c = __builtin_amdgcn_cosf(fr); s = __builtin_amdgcn_sinf(fr);
}
__device__ __forceinline__ void p0_prologue(const Ptrs& P, LAS float* scr, int gw, int ngw, int lane) {
    unsigned char* ws = P.ws;
    constexpr int I_INA = (DM / 64) * (NA_IN / 32), I_OUTA = (DM / 64) * (DM / 32), I_INB = (DM / 64) * (NB_IN / 32), I_OUTB = (BV / 64) * (DM / 32);
    constexpr int NITEMS = I_INA + I_OUTA + I_INB + I_OUTB;
    for (int it = gw; it < NITEMS; it += ngw) {
        int r = it;
        if (r < I_INA) { p0_transpose_item(P.w_in_a, nullptr, DM, NA_IN, (bf16_t*)(ws + WS_WINA), scr, r, lane); continue; } r -= I_INA;
        if (r < I_OUTA) { p0_transpose_item(P.w_out_a, nullptr, DM, DM, (bf16_t*)(ws + WS_WOUTA), scr, r, lane); continue; } r -= I_OUTA;
        if (r < I_INB) { p0_transpose_item(P.w_in_b, P.norm_b, DM, NB_IN, (bf16_t*)(ws + WS_WINB), scr, r, lane); continue; } r -= I_INB;
        p0_transpose_item(P.w_out_b, nullptr, BV, DM, (bf16_t*)(ws + WS_WOUTB), scr, r, lane);
    }
    bf16_t* XN = (bf16_t*)(ws + WS_XN0);
    for (int m = gw; m < MT; m += ngw) p0_norm_row(m < MP ? P.x_p + (size_t)m * DM : P.x_s + (size_t)(m - MP) * DM, P.norm_a, XN + (size_t)m * DM, lane);
    float* rc = (float*)(ws + WS_ROPE); float* rs = rc + 2048 * 8;
    for (int i = gw * 64 + lane; i < 2048 * 8; i += ngw * 64) { const int pos = i >> 3, k = i & 7;
        const float inv = (float)exp2(-18.931568569324174 * (double)k / 8.0);
        float c, s; sincos_rev((float)pos * inv, c, s); rc[i] = c; rs[i] = s; }
    float* xc = (float*)(ws + WS_XPOS); float* xs = xc + 2048 * 128;
    for (int i = gw * 64 + lane; i < 2048 * 128; i += ngw * 64) { const int pos = i >> 7, k = i & 127;
        const float e = (float)k * (1.0f / 127.0f);
        const float inv = 1.0f / (float)exp2(13.287712379549449 * (double)e);
        float c, s; sincos_rev((float)pos * inv, c, s); xc[i] = c; xs[i] = s; }
    if (gw == 0) { float a = P.lq1[lane] * P.lk1[lane], b = P.lq2[lane] * P.lk2[lane]; a = wave_sum(a); b = wave_sum(b);
        if (lane == 0) *(float*)(ws + WS_LAM) = expf(a) - expf(b) + LAMBDA_INIT; }
}
namespace orc {
template <class E>
__global__ __launch_bounds__(256) void s_gemm(const bf16_t* __restrict__ A, const bf16_t* __restrict__ Bt, int K, E e) {
    const int wave = threadIdx.x >> 6, lane = threadIdx.x & 63, l15 = lane & 15, kq = lane >> 4;
    const int row0 = blockIdx.y * 64 + (wave >> 1) * 32, col0 = blockIdx.x * 64 + (wave & 1) * 32;
    f32x4 acc[2][2];
#pragma unroll
    for (int i = 0; i < 2; ++i)
#pragma unroll
        for (int j = 0; j < 2; ++j) acc[i][j] = (f32x4){0.f, 0.f, 0.f, 0.f};
    const bf16_t* ap = A + (size_t)(row0 + l15) * K + kq * 8; const bf16_t* bp = Bt + (size_t)(col0 + l15) * K + kq * 8;
    for (int k = 0; k < K; k += 32) {
        bf16x8 a[2], b[2];
#pragma unroll
        for (int i = 0; i < 2; ++i) { a[i] = *(const bf16x8*)(ap + (size_t)i * 16 * K + k); b[i] = *(const bf16x8*)(bp + (size_t)i * 16 * K + k); }
#pragma unroll
        for (int i = 0; i < 2; ++i)
#pragma unroll
            for (int j = 0; j < 2; ++j) acc[i][j] = __builtin_amdgcn_mfma_f32_16x16x32_bf16(a[i], b[j], acc[i][j], 0, 0, 0);
    }
#pragma unroll
    for (int i = 0; i < 2; ++i)
#pragma unroll
        for (int j = 0; j < 2; ++j)
#pragma unroll
            for (int r = 0; r < 4; ++r) e(row0 + i * 16 + kq * 4 + r, col0 + j * 16 + l15, acc[i][j][r]);
}
struct ERaw { bf16_t* base; int secw, ld; size_t stride; const float* ssq;
    __device__ void operator()(int row, int col, float v) const { const int s = col / secw;
        if (ssq) v *= 1.0f / sqrtf(ssq[row] * (1.f / DM) + NORM_EPS);
        base[(size_t)s * stride + (size_t)row * ld + (col - s * secw)] = (bf16_t)f2bf(v); } };
struct ERaw3 { bf16_t *q, *k, *v, *g; const float* ssq;
    __device__ void operator()(int row, int col, float x) const { x *= 1.0f / sqrtf(ssq[row] * (1.f / DM) + NORM_EPS); const bf16_t o = (bf16_t)f2bf(x);
        if (col < 2048) q[(size_t)row * DM + col] = o; else if (col < 4096) k[(size_t)row * DM + col - 2048] = o;
        else if (col < 8192) v[(size_t)row * BV + col - 4096] = o; else g[(size_t)row * BV + col - 8192] = o; } };
struct ERes1 { const float *xp, *xs; float* out; bf16_t* xb;
    __device__ void operator()(int row, int col, float v) const {
        const float x = row < MP ? xp[(size_t)row * DM + col] : xs[(size_t)(row - MP) * DM + col];
        float* o = row < MP ? out + OUT_Y_P + (size_t)row * DM + col : out + OUT_Y_S + (size_t)(row - MP) * DM + col;
        const float r = x + v; *o = r; xb[(size_t)row * DM + col] = (bf16_t)f2bf(r); } };
struct ERes2 { float* out;
    __device__ void operator()(int row, int col, float v) const {
        float* o = row < MP ? out + OUT_Y_P + (size_t)row * DM + col : out + OUT_Y_S + (size_t)(row - MP) * DM + col; *o += v; } };

__global__ __launch_bounds__(256) void s_post1(Ptrs P) {
    const size_t idx = (size_t)blockIdx.x * 256 + threadIdx.x; if (idx >= (size_t)MT * NA_IN) return;
    const int row = (int)(idx / NA_IN), col = (int)(idx % NA_IN), sec = col >> 11, c = col & 2047, c64 = c & 63;
    bf16_t* buf = (bf16_t*)(P.ws + WS_Q0) + (size_t)sec * (ACT / 2) + (size_t)row * DM;
    const float* rc = (const float*)(P.ws + WS_ROPE); const float* rs = rc + 2048 * 8; const int pos = row_pos(row);
    float* ko = row < MP ? P.out + OUT_K_P + (size_t)row * DM : P.out + OUT_K_S + (size_t)(row - MP) * DM;
    float* vo = row < MP ? P.out + OUT_V_P + (size_t)row * DM : P.out + OUT_V_S + (size_t)(row - MP) * DM;
    if (sec <= 1) {
        if (c64 >= 8 && c64 < 16) return;
        if (c64 < 8) { const float x1 = bf2f(buf[c]), x2 = bf2f(buf[c + 8]), cs = rc[pos * 8 + c64], sn = rs[pos * 8 + c64];
            float o1 = x1 * cs - x2 * sn, o2 = x1 * sn + x2 * cs;
            if (sec == 0) { o1 *= QSCALE; o2 *= QSCALE; } else { ko[c] = o1; ko[c + 8] = o2; }
            buf[c] = (bf16_t)f2bf(o1); buf[c + 8] = (bf16_t)f2bf(o2); }
        else { float x = bf2f(buf[c]); if (sec == 0) { x *= QSCALE; buf[c] = (bf16_t)f2bf(x); } else ko[c] = x; }
    } else if (sec == 2) { vo[c] = bf2f(buf[c]); }
    else { buf[c] = (bf16_t)f2bf(silu_f(bf2f(buf[c]))); }
}
__global__ __launch_bounds__(256) void s_post3(Ptrs P) {
    const size_t idx = (size_t)blockIdx.x * 256 + threadIdx.x; if (idx >= (size_t)MT * NB_IN) return;
    const int row = (int)(idx / NB_IN), col = (int)(idx % NB_IN);
    const float* xc = (const float*)(P.ws + WS_XPOS); const float* xs = xc + 2048 * 128; const int pos = row_pos(row);
    if (col < 4096) { const int sec = col >> 11, c = col & 2047, c256 = c & 255; if (c256 >= 128) return;
        bf16_t* buf = (bf16_t*)(P.ws + (sec == 0 ? WS_XN0 : WS_K0)) + (size_t)row * DM;
        const float x1 = bf2f(buf[c]), x2 = bf2f(buf[c + 128]), cs = xc[pos * 128 + c256], sn = xs[pos * 128 + c256];
        float o1 = x1 * cs - x2 * sn, o2 = x1 * sn + x2 * cs; if (sec == 1) { o1 *= 0.0625f; o2 *= 0.0625f; }
        buf[c] = (bf16_t)f2bf(o1); buf[c + 128] = (bf16_t)f2bf(o2);
    } else if (col >= 8192) { bf16_t* g = (bf16_t*)(P.ws + WS_GR) + (size_t)row * BV + (col - 8192); *g = (bf16_t)f2bf(silu_f(bf2f(*g))); }
}
__device__ __forceinline__ float block_sum128(float v, float* red) {
    v = wave_sum(v); __syncthreads(); if ((threadIdx.x & 63) == 0) red[threadIdx.x >> 6] = v; __syncthreads(); return red[0] + red[1]; }
__device__ __forceinline__ float block_max128(float v, float* red) {
#pragma unroll
    for (int o = 1; o < 64; o <<= 1) v = fmaxf(v, __shfl_xor(v, o));
    __syncthreads(); if ((threadIdx.x & 63) == 0) red[threadIdx.x >> 6] = v; __syncthreads(); return fmaxf(red[0], red[1]); }
__global__ __launch_bounds__(128) void s_attn(Ptrs P, int sample) {
    __shared__ float sc0[2112], sc1[2112], qs[128], red[2];
    const int tid = threadIdx.x, h = blockIdx.y; int row, b, nkeys;
    if (!sample) { row = blockIdx.x; b = row >> 11; nkeys = (((row & 2047) >> 6) + 1) << 6; } else { b = blockIdx.x >> 4; row = MP + blockIdx.x; nkeys = PAST + DSEQ; }
    const bf16_t* Q0 = (const bf16_t*)(P.ws + WS_Q0); const bf16_t* K0 = (const bf16_t*)(P.ws + WS_K0); const bf16_t* V0 = (const bf16_t*)(P.ws + WS_V0); const bf16_t* G0 = (const bf16_t*)(P.ws + WS_G0);
    bf16_t* O0 = (bf16_t*)(P.ws + WS_XN0);
    qs[tid] = bf2f(Q0[(size_t)row * DM + h * 128 + tid]); __syncthreads();
    float m0 = -1e30f, m1 = -1e30f;
#pragma unroll 1
    for (int j = tid; j < nkeys; j += 128) { float s0 = 0.f, s1 = 0.f;
        if (sample && j < PAST) { const float* kr = P.ck + ((size_t)(b * PAST + j)) * DM + h * 128;
#pragma unroll 8
            for (int d = 0; d < 64; ++d) { s0 += qs[d] * kr[d]; s1 += qs[64 + d] * kr[64 + d]; } }
        else { const size_t kr_row = sample ? (size_t)(MP + b * DSEQ + (j - PAST)) : (size_t)((b << 11) + j); const bf16_t* kr = K0 + kr_row * DM + h * 128;
#pragma unroll 8
            for (int d = 0; d < 64; ++d) { s0 += qs[d] * bf2f(kr[d]); s1 += qs[64 + d] * bf2f(kr[64 + d]); } }
        sc0[j] = s0; sc1[j] = s1; m0 = fmaxf(m0, s0); m1 = fmaxf(m1, s1); }
    m0 = block_max128(m0, red); m1 = block_max128(m1, red);
    float l0 = 0.f, l1 = 0.f;
    for (int j = tid; j < nkeys; j += 128) { const float p0 = exp2f(sc0[j] - m0), p1 = exp2f(sc1[j] - m1); sc0[j] = p0; sc1[j] = p1; l0 += p0; l1 += p1; }
    l0 = block_sum128(l0, red); l1 = block_sum128(l1, red);
    const float lam = *(const float*)(P.ws + WS_LAM), i0 = 1.0f / l0, i1 = lam / l1;
    __syncthreads();
    float o = 0.f;
#pragma unroll 4
    for (int j = 0; j < nkeys; ++j) { const float a = sc0[j] * i0 - sc1[j] * i1; float v;
        if (sample && j < PAST) v = P.cv[((size_t)(b * PAST + j)) * DM + h * 128 + tid];
        else { const size_t vr = sample ? (size_t)(MP + b * DSEQ + (j - PAST)) : (size_t)((b << 11) + j); v = bf2f(V0[vr * DM + h * 128 + tid]); }
        o += a * v; }
    const float ssq = block_sum128(o * o, red);
    const float r = 1.0f / sqrtf(ssq * (1.f / 128.f) + SUBLN_EPS);
    const float res = o * r * P.subln[tid] * (1.0f - LAMBDA_INIT) * bf2f(G0[(size_t)row * DM + h * 128 + tid]);
    O0[(size_t)row * DM + h * 128 + tid] = (bf16_t)f2bf(res);
}
__global__ __launch_bounds__(256) void s_rowssq(Ptrs P) {
    const int row = blockIdx.x * 4 + (threadIdx.x >> 6), lane = threadIdx.x & 63; if (row >= MT) return;
    const float* x = row < MP ? P.out + OUT_Y_P + (size_t)row * DM : P.out + OUT_Y_S + (size_t)(row - MP) * DM; float s = 0.f;
    for (int i = lane; i < DM; i += 64) s += x[i] * x[i];
    s = wave_sum(s); if (lane == 0) ((float*)(P.ws + WS_SSQ1))[row] = s;
}
__global__ __launch_bounds__(256) void s_ret(Ptrs P) {
    __shared__ bf16_t qs[64 * 256], ks[64 * 256]; __shared__ float vs[64 * 64], sc[64 * 65], ys[64 * 64];
    const int tid = threadIdx.x, dvc = tid & 63, kq = tid >> 6, sl = blockIdx.x, h = blockIdx.y, unit = blockIdx.z;
    const bool smp = unit >= 16; const int b = unit & 15, nch = smp ? 1 : 32, L = smp ? DSEQ : 64; const size_t row0 = smp ? (size_t)MP + b * DSEQ : (size_t)b * SEQ;
    const bf16_t* Qr = (const bf16_t*)(P.ws + WS_XN0); const bf16_t* Kr = (const bf16_t*)(P.ws + WS_K0); const bf16_t* Vr = (const bf16_t*)(P.ws + WS_V0); bf16_t* Gr = (bf16_t*)(P.ws + WS_GR);
    float* ssqR = (float*)(P.ws + WS_SSQR);
    const float lg = log1pf(-exp2f(-5.0f - (float)h));
    float S[64];
    const size_t st_off = (((size_t)b * 8 + h) * 256) * 512 + sl * 64 + dvc;
#pragma unroll
    for (int i = 0; i < 64; ++i) S[i] = smp ? P.st[st_off + (size_t)(64 * kq + i) * 512] : 0.f;
    for (int c = 0; c < nch; ++c) { const size_t r0 = row0 + (size_t)c * 64;
        for (int i = tid; i < 64 * 256; i += 256) { const int t = i >> 8, d = i & 255; const bool ok = t < L;
            qs[i] = ok ? Qr[(r0 + t) * DM + h * 256 + d] : (bf16_t)0; ks[i] = ok ? Kr[(r0 + t) * DM + h * 256 + d] : (bf16_t)0; }
        for (int i = tid; i < 64 * 64; i += 256) { const int t = i >> 6, d = i & 63; vs[i] = t < L ? bf2f(Vr[(r0 + t) * BV + h * 512 + sl * 64 + d]) : 0.f; ys[i] = 0.f; }
        __syncthreads();
        for (int i = 0; i < 16; ++i) { const int id = tid * 16 + i, tq = id >> 6, tk = id & 63; float s = 0.f;
            for (int d = 0; d < 256; ++d) s += bf2f(qs[tq * 256 + d]) * bf2f(ks[tk * 256 + d]);
            sc[tq * 65 + tk] = s * expf(lg * fabsf((float)(tq - tk))); }
        for (int t = 0; t < 64; ++t) { float p = 0.f;
#pragma unroll
            for (int i = 0; i < 64; ++i) p += bf2f(qs[t * 256 + 64 * kq + i]) * S[i];
            atomicAdd(&ys[t * 64 + dvc], p * expf(lg * (float)(t + 1))); }
        __syncthreads();
        for (int t = kq * 16; t < kq * 16 + 16; ++t) { float y = ys[t * 64 + dvc];
            for (int tk = 0; tk < 64; ++tk) y += sc[t * 65 + tk] * vs[tk * 64 + dvc];
            ys[t * 64 + dvc] = y; }
        const float cd = expf(lg * (float)L);
#pragma unroll
        for (int i = 0; i < 64; ++i) S[i] *= cd;
        for (int t = 0; t < L; ++t) { const float vd = vs[t * 64 + dvc] * expf(lg * (float)(L - 1 - t));
#pragma unroll
            for (int i = 0; i < 64; ++i) S[i] += bf2f(ks[t * 256 + 64 * kq + i]) * vd; }
        for (int t = kq * 16; t < kq * 16 + 16; ++t) { const float y = ys[t * 64 + dvc]; const float q = wave_sum(y * y);
            if (t < L) { bf16_t* g = Gr + (r0 + t) * BV + h * 512 + sl * 64 + dvc; *g = (bf16_t)f2bf(y * bf2f(*g));
                if (dvc == 0) atomicAdd(&ssqR[(r0 + t) * 16 + h * 2 + (sl >> 2)], q); } }
        __syncthreads();
    }
    float* so = P.out + (smp ? OUT_ST_S : OUT_ST_P) + st_off;
#pragma unroll
    for (int i = 0; i < 64; ++i) so[(size_t)(64 * kq + i) * 512] = S[i];
}
__global__ __launch_bounds__(256) void s_norm_o1(Ptrs P) {
    const size_t idx = (size_t)blockIdx.x * 256 + threadIdx.x; if (idx >= (size_t)MT * BV) return;
    const size_t row = idx / BV; const int col = (int)(idx % BV), h = col >> 9; const float* q = (const float*)(P.ws + WS_SSQR) + row * 16 + h * 2;
    bf16_t* g = (bf16_t*)(P.ws + WS_GR) + idx; *g = (bf16_t)f2bf(bf2f(*g) / sqrtf((q[0] + q[1]) * (1.f / 512.f) + NORM_EPS));
}
}
#define XB_TMO      128
#define XB_XCNT(j)  (256  + 64 * (j))
#define XB_XSUB(j)  (1280 + 64 * (j))
#define XB_XGEN(j)  (2304 + 64 * (j))
#define XB_TOP      3328
#define XB_TOPGEN   3392
#define XCD_BAR_WORDS 3456
#define XB_SPIN_CAP (1u << 18)
__device__ __forceinline__ unsigned xb_ld(unsigned* p)              { return __hip_atomic_load(p, __ATOMIC_RELAXED, __HIP_MEMORY_SCOPE_AGENT); }
__device__ __forceinline__ unsigned xb_add(unsigned* p, unsigned v) { return __hip_atomic_fetch_add(p, v, __ATOMIC_RELAXED, __HIP_MEMORY_SCOPE_AGENT); }
__device__ __forceinline__ unsigned xb_xcc_id() { return (unsigned)__builtin_amdgcn_s_getreg((3 << 11) | 20) & 0xFu; }
#define XB_SPIN(cond, bar) do { unsigned _sp = 0; while (cond) { __builtin_amdgcn_s_sleep(1); \
    if ((++_sp & 255u) == 0u) { if (xb_ld(&(bar)[XB_TMO])) break; if (_sp > XB_SPIN_CAP) { atomicAdd(&(bar)[XB_TMO], 1u); break; } } } } while (0)
struct XcdBarrier { unsigned* bar; unsigned x; volatile LAS unsigned* st; };
__device__ __forceinline__ XcdBarrier xcd_barrier_post(unsigned* bar, volatile LAS unsigned* st) {
    XcdBarrier b; b.bar = bar; b.x = xb_xcc_id(); b.st = st;
    if (threadIdx.x == 0) (void)xb_add(&bar[XB_XCNT(b.x)], 1u);
    return b;
}
__device__ __forceinline__ void xcd_barrier_complete(unsigned* bar, unsigned x, unsigned& nloc, unsigned& nx) {
    const unsigned G = gridDim.x * gridDim.y * gridDim.z;
    unsigned sum, cnt, mine, sp = 0u;
    for (;;) {
        sum = 0u; cnt = 0u; mine = 0u;
#pragma unroll
        for (unsigned j = 0; j < 16; ++j) { const unsigned c = xb_ld(&bar[XB_XCNT(j)]); sum += c; cnt += (c > 0u) ? 1u : 0u; mine = (j == x) ? c : mine; }
        if (sum == G) break;
        __builtin_amdgcn_s_sleep(1);
        if ((++sp & 255u) == 0u) { if (xb_ld(&bar[XB_TMO])) break; if (sp > XB_SPIN_CAP) { atomicAdd(&bar[XB_TMO], 1u); break; } }
    }
    nloc = mine > 0u ? mine : 1u; nx = cnt > 0u ? cnt : 1u;
}
__device__ __forceinline__ void xcd_barrier(const XcdBarrier& b) {
    asm volatile("s_waitcnt vmcnt(0)" ::: "memory");
    __syncthreads();
    if (threadIdx.x == 0) {
        unsigned* bar = b.bar;
        __builtin_amdgcn_s_waitcnt(0);
        unsigned nloc = b.st[0], nx = b.st[1];
        if (nloc == 0u) { xcd_barrier_complete(bar, b.x, nloc, nx); b.st[0] = nloc; b.st[1] = nx; }
        const unsigned old = xb_add(&bar[XB_XSUB(b.x)], 1u);
        const unsigned gen = old / nloc;
        if (old + 1u == (gen + 1u) * nloc) {
            __builtin_amdgcn_fence(__ATOMIC_RELEASE, "agent");
            asm volatile("s_waitcnt vmcnt(0)" ::: "memory");
            const unsigned og = xb_add(&bar[XB_TOP], 1u);
            const unsigned tg = og / nx;
            if (og + 1u == (tg + 1u) * nx) xb_add(&bar[XB_TOPGEN], 1u);
            else XB_SPIN(xb_ld(&bar[XB_TOPGEN]) == tg, bar);
            __builtin_amdgcn_fence(__ATOMIC_ACQUIRE, "agent");
            xb_add(&bar[XB_XGEN(b.x)], 1u);
            asm volatile("s_waitcnt vmcnt(0)" ::: "memory");
        } else {
            XB_SPIN(xb_ld(&bar[XB_XGEN(b.x)]) == gen, bar);
            __builtin_amdgcn_fence(__ATOMIC_ACQUIRE, "agent");
            asm volatile("s_waitcnt vmcnt(0)" ::: "memory");
        }
    }
    __syncthreads();
}

constexpr int RING_BYTES = 131072;
constexpr int MISC_OFF = RING_BYTES + 320;
constexpr int LDS_BYTES = 147456;
constexpr int NWAVES = 8;

__device__ __forceinline__ int fresh_lane() { int z; asm volatile("v_mov_b32 %0, 0" : "=v"(z)); return (int)__builtin_amdgcn_mbcnt_hi(~0u, __builtin_amdgcn_mbcnt_lo(~0u, (unsigned)z)); }
__device__ __forceinline__ void p7_final(const Ptrs& P, int gw, int ngw, int lane) {
    for (int m = gw; m < MT; m += ngw) {
        float* xrow = m < MP ? P.out + OUT_Y_P + (size_t)m * DM : P.out + OUT_Y_S + (size_t)(m - MP) * DM;
        f32x4* xr = (f32x4*)xrow + lane; const f32x4* gr = (const f32x4*)P.norm_f + lane;
        f32x4 v[8]; float s = 0.f;
#pragma unroll
        for (int j = 0; j < 8; ++j) { v[j] = xr[64 * j]; s += (v[j].x * v[j].x + v[j].y * v[j].y) + (v[j].z * v[j].z + v[j].w * v[j].w); }
        const float r = 1.0f / sqrtf(wave_sum(s) * (1.f / DM) + NORM_EPS);
#pragma unroll
        for (int j = 0; j < 8; ++j) { const f32x4 gg = gr[64 * j]; xr[64 * j] = (f32x4){v[j].x * r * gg.x, v[j].y * r * gg.y, v[j].z * r * gg.z, v[j].w * r * gg.w}; }
    }
}
namespace pg8 {
#define PG8_LAS __attribute__((address_space(3)))
constexpr int BM = 256, BK = 64, HALF = 128, HTB = HALF * BK * 2  , STAGE_BYTES = 8 * HTB, NXCD = 8, WGM = 8;

__host__ __device__ __forceinline__ int lds_byte(int r, int c) { const int st = (r >> 4) * 2 + (c >> 5), rr = r & 15, cc = c & 31, ob = rr * 64 + cc * 2; return st * 1024 + (ob ^ (((ob >> 9) & 1) << 5)); }
__host__ __device__ __forceinline__ void stage_rc(int b, int& R, int& C) { const int st = b / 1024, sb = b % 1024, swz = sb ^ (((sb >> 9) & 1) << 5); R = (st >> 1) * 16 + swz / 64; C = (st & 1) * 32 + (swz % 64) / 2; }
__host__ __device__ __forceinline__ int perm32(int rho) { const int n = rho >> 4, i = rho & 15; return 8 * (i >> 2) + 4 * n + (i & 3); }

struct Unit { int pm, pn; };
struct Gemm { const bf16_t* A; const bf16_t* Bt; int M, N, K; };

struct StaticOrder {
    int nM, nN, nwg, G, c;
    __host__ __device__ void init(int M, int N, int G_, int c_) { nM = M / BM; nN = N / BM; nwg = nM * nN; G = G_; c = c_; }
    __host__ __device__ bool next(int i, Unit& u) const {
        const long L = (long)i * G + c; if (L >= nwg) return false;
        int wgid = (int)L; { const int q = nwg / NXCD, r = nwg % NXCD, xcd = wgid % NXCD, off = wgid / NXCD; wgid = (xcd < r ? xcd * (q + 1) : r * (q + 1) + (xcd - r) * q) + off; }
        const int nig = WGM * nN, gid = wgid / nig, fm = gid * WGM, gsz = (nM - fm) < WGM ? (nM - fm) : WGM;
        u.pm = fm + ((wgid % nig) % gsz); u.pn = (wgid % nig) / gsz; return true;
    }
    __device__ __forceinline__ void a_ready(const Unit&) const {}
    __device__ __forceinline__ void done(const Unit&) const {}
};

__device__ __forceinline__ unsigned cvt_pk_bf16(float lo, float hi) { unsigned r; asm volatile("v_cvt_pk_bf16_f32 %0, %1, %2" : "=v"(r) : "v"(lo), "v"(hi)); return r; }
typedef float f32x2 __attribute__((ext_vector_type(2)));
__device__ __forceinline__ u32x4 pack8(f32x4 a, f32x4 b) { u32x4 w; w.x = cvt_pk_bf16(a[0], a[1]); w.y = cvt_pk_bf16(a[2], a[3]); w.z = cvt_pk_bf16(b[0], b[1]); w.w = cvt_pk_bf16(b[2], b[3]); return w; }
__device__ __forceinline__ f32x4 shx16(f32x4 v) { f32x4 r; r[0] = __shfl_xor(v[0], 16); r[1] = __shfl_xor(v[1], 16); r[2] = __shfl_xor(v[2], 16); r[3] = __shfl_xor(v[3], 16); return r; }
__device__ __forceinline__ f32x4 silu4(f32x4 v) { return (f32x4){silu_f(v[0]), silu_f(v[1]), silu_f(v[2]), silu_f(v[3])}; }
__device__ __forceinline__ float dot4(f32x4 a) { return (a[0] * a[0] + a[1] * a[1]) + (a[2] * a[2] + a[3] * a[3]); }
struct EpiA1 {
    static constexpr bool PERM = true, AFTER_DRAIN = false, KHOOK = false;
    bf16_t* Q0; float* out; const float* ropeC; const float* ropeS;
    __device__ __forceinline__ void operator()(const f32x4 (&acc)[2][2][4][2], const Unit& u, int wr, int wc, int fr, int fq) const {
        const int sec = u.pn >> 3, col0 = (u.pn & 7) * BM + wc * 32 + 8 * fq;
        bf16_t* base = Q0 + (size_t)sec * (ACT / 2);
        const bool rot = (sec <= 1) && ((wc & 1) == 0);
#pragma unroll
        for (int ai = 0; ai < 2; ++ai)
#pragma unroll
            for (int m = 0; m < 4; ++m) {
                const int row = u.pm * BM + ai * HALF + wr * 64 + m * 16 + fr, pos = row_pos(row);
                f32x4 c0 = {1.f, 1.f, 1.f, 1.f}, c1 = c0, s0 = {0.f, 0.f, 0.f, 0.f}, s1 = s0;
                if (rot && fq < 2) { c0 = *(const f32x4*)(ropeC + pos * 8); c1 = *(const f32x4*)(ropeC + pos * 8 + 4); s0 = *(const f32x4*)(ropeS + pos * 8); s1 = *(const f32x4*)(ropeS + pos * 8 + 4); }
                float* fo = nullptr;
                if (sec == 1) fo = row < MP ? out + OUT_K_P + (size_t)row * DM : out + OUT_K_S + (size_t)(row - MP) * DM;
                else if (sec == 2) fo = row < MP ? out + OUT_V_P + (size_t)row * DM : out + OUT_V_S + (size_t)(row - MP) * DM;
#pragma unroll
                for (int bj = 0; bj < 2; ++bj) { f32x4 v0 = acc[ai][bj][m][0], v1 = acc[ai][bj][m][1]; const int col = col0 + bj * HALF;
                    if (rot) { const f32x4 p0 = shx16(v0), p1 = shx16(v1);
                        if (fq == 0) { v0 = v0 * c0 - p0 * s0; v1 = v1 * c1 - p1 * s1; } else if (fq == 1) { v0 = p0 * s0 + v0 * c0; v1 = p1 * s1 + v1 * c1; } }
                    if (sec == 0) { v0 = v0 * QSCALE; v1 = v1 * QSCALE; } else if (sec == 3) { v0 = silu4(v0); v1 = silu4(v1); }
                    if (fo) { *(f32x4*)(fo + col) = v0; *(f32x4*)(fo + col + 4) = v1; }
                    *(u32x4*)(base + (size_t)row * DM + col) = pack8(v0, v1); }
            }
    }
};
struct EpiA2 {
    static constexpr bool PERM = true, AFTER_DRAIN = false, KHOOK = false;
    const float *xp, *xs; float* out; bf16_t* xb; float* ssq;
    __device__ __forceinline__ void operator()(const f32x4 (&acc)[2][2][4][2], const Unit& u, int wr, int wc, int fr, int fq) const {
        const int col0 = u.pn * BM + wc * 32 + 8 * fq;
#pragma unroll
        for (int ai = 0; ai < 2; ++ai)
#pragma unroll
            for (int m = 0; m < 4; ++m) {
                const int row = u.pm * BM + ai * HALF + wr * 64 + m * 16 + fr;
                const float* xi = row < MP ? xp + (size_t)row * DM : xs + (size_t)(row - MP) * DM;
                float* xo = row < MP ? out + OUT_Y_P + (size_t)row * DM : out + OUT_Y_S + (size_t)(row - MP) * DM;
                float q = 0.f;
#pragma unroll
                for (int bj = 0; bj < 2; ++bj) { const int col = col0 + bj * HALF;
                    const f32x4 a0 = *(const f32x4*)(xi + col) + acc[ai][bj][m][0], a1 = *(const f32x4*)(xi + col + 4) + acc[ai][bj][m][1];
                    *(f32x4*)(xo + col) = a0; *(f32x4*)(xo + col + 4) = a1; *(u32x4*)(xb + (size_t)row * DM + col) = pack8(a0, a1); q += dot4(a0) + dot4(a1); }
                q += __shfl_xor(q, 16); q += __shfl_xor(q, 32);
                if (fq == 0) unsafeAtomicAdd(ssq + row, q);
                if (m & 1) asm volatile("" ::: "memory");
            }
    }
};
struct EpiB1 {
    static constexpr bool PERM = true, AFTER_DRAIN = false, KHOOK = false;
    bf16_t *q, *k, *v, *g; const float* ssq; const float *xc, *xs;
    __device__ __forceinline__ void operator()(const f32x4 (&acc)[2][2][4][2], const Unit& u, int wr, int wc, int fr, int fq) const {
        const int pn = u.pn, c0 = wc * 32 + 8 * fq;
#pragma unroll
        for (int ai = 0; ai < 2; ++ai)
#pragma unroll
            for (int m = 0; m < 4; ++m) {
                const int row = u.pm * BM + ai * HALF + wr * 64 + m * 16 + fr, pos = row_pos(row);
                const float r = 1.0f / sqrtf(ssq[row] * (1.f / DM) + NORM_EPS);
                if (pn < 16) {
                    bf16_t* dst = (pn < 8 ? q : k) + (size_t)row * DM + (pn & 7) * 256 + c0; const float ks = (pn < 8 ? 1.0f : 0.0625f) * r;
                    f32x4 o1[2], o2[2];
#pragma unroll
                    for (int n = 0; n < 2; ++n) { const f32x4 c = *(const f32x4*)(xc + pos * 128 + c0 + 4 * n), s = *(const f32x4*)(xs + pos * 128 + c0 + 4 * n);
                        const f32x4 x1 = acc[ai][0][m][n] * ks, x2 = acc[ai][1][m][n] * ks; o1[n] = x1 * c - x2 * s; o2[n] = x1 * s + x2 * c; }
                    *(u32x4*)dst = pack8(o1[0], o1[1]); *(u32x4*)(dst + HALF) = pack8(o2[0], o2[1]);
                } else {
                    const bool isg = pn >= 32; bf16_t* dst = (isg ? g : v) + (size_t)row * BV + (pn - (isg ? 32 : 16)) * 256 + c0;
#pragma unroll
                    for (int bj = 0; bj < 2; ++bj) { f32x4 v0 = acc[ai][bj][m][0] * r, v1 = acc[ai][bj][m][1] * r; if (isg) { v0 = silu4(v0); v1 = silu4(v1); }
                        *(u32x4*)(dst + bj * HALF) = pack8(v0, v1); }
                }
            }
    }
};
struct EpiB2 {
    static constexpr bool PERM = true, AFTER_DRAIN = false, KHOOK = true;
    float* out; const float* ssqR;
    __device__ __forceinline__ void khook(f32x4 (&acc)[2][2][4][2], const Unit& u, int h, int wr, int fr) const {
        typedef float f32x2 __attribute__((ext_vector_type(2)));
        __builtin_amdgcn_sched_barrier(0);
        int z_ = 0; asm volatile("v_mov_b32 %0, 0" : "=v"(z_));
        const int fr_ = (int)__builtin_amdgcn_mbcnt_hi(~0u, __builtin_amdgcn_mbcnt_lo(~0u, (unsigned)z_)) & 15;
        const float* qb = ssqR + (size_t)(u.pm * BM + wr * 64 + fr_) * 16 + h * 2;
#pragma unroll
        for (int ai = 0; ai < 2; ++ai)
#pragma unroll
            for (int m = 0; m < 4; ++m) {
                const float* q = qb + (ai * HALF + m * 16) * 16;
                const f32x2 cur = *(const f32x2*)q, prv = *(const f32x2*)(q - 2);
                const float f = sqrtf(((cur.x + cur.y) * (1.f / 512.f) + NORM_EPS) / ((prv.x + prv.y) * (1.f / 512.f) + NORM_EPS));
#pragma unroll
                for (int bj = 0; bj < 2; ++bj)
#pragma unroll
                    for (int n = 0; n < 2; ++n) acc[ai][bj][m][n] *= f;
                asm volatile("" : "+v"(acc[ai][0][m][0]), "+v"(acc[ai][0][m][1]), "+v"(acc[ai][1][m][0]), "+v"(acc[ai][1][m][1]) :: "memory");
            }
        __builtin_amdgcn_sched_barrier(0);
    }
    __device__ __forceinline__ void operator()(const f32x4 (&acc)[2][2][4][2], const Unit& u, int wr, int wc, int fr, int fq) const {
        const int col0 = u.pn * BM + wc * 32 + 8 * fq;
#pragma unroll
        for (int ai = 0; ai < 2; ++ai)
#pragma unroll
            for (int m = 0; m < 4; ++m) {
                const int row = u.pm * BM + ai * HALF + wr * 64 + m * 16 + fr; const float* q = ssqR + (size_t)row * 16 + 14;
                const float r7 = 1.0f / sqrtf((q[0] + q[1]) * (1.f / 512.f) + NORM_EPS);
                float* xo = row < MP ? out + OUT_Y_P + (size_t)row * DM : out + OUT_Y_S + (size_t)(row - MP) * DM;
#pragma unroll
                for (int bj = 0; bj < 2; ++bj) { const int col = col0 + bj * HALF;
                    *(f32x4*)(xo + col) = *(const f32x4*)(xo + col) + acc[ai][bj][m][0] * r7; *(f32x4*)(xo + col + 4) = *(const f32x4*)(xo + col + 4) + acc[ai][bj][m][1] * r7; }
                if (m & 1) asm volatile("" ::: "memory");
            }
    }
};
template <class Epi, class Sched, bool ALIGN_EPI = false, bool SP2 = false>
__device__ __forceinline__ void gemm_phase(PG8_LAS unsigned char* lds, const Gemm g, const Sched& S, const Epi& E) {
    const int tid = threadIdx.x, wid = __builtin_amdgcn_readfirstlane(tid >> 6), lane = tid & 63, wr = wid >> 2, wc = wid & 3, fr = lane & 15, fq = lane >> 4;
    const int K = g.K, nt = K / BK;
    unsigned voffA[2], voffB[2];
#pragma unroll
    for (int i = 0; i < 2; ++i) { int R, C; stage_rc(tid * 16 + i * 8192, R, C); const int Rb = Epi::PERM ? ((R & ~31) + perm32(R & 31)) : R;
        voffA[i] = (unsigned)(R * K + C) * 2u; voffB[i] = (unsigned)(Rb * K + C) * 2u; }
    const size_t kstep = (size_t)(BK * 2);
    const size_t hstep = (size_t)HALF * K * 2;
    const size_t tstep = 2 * hstep;
    const unsigned ldsw = (unsigned)wid * 1024u;
    const int aoff = lds_byte(wr * 64 + fr, fq * 8), boff = lds_byte(wc * 32 + fr, fq * 8);
#define PG8_SA(b, h) (((b) * 2 + (h)) * HTB)
#define PG8_SB(b, h) ((4 + (b) * 2 + (h)) * HTB)
#define PG8_STAGE(bufoff, gbase, voff) do { _Pragma("unroll") for (int _i = 0; _i < 2; ++_i) \
        __builtin_amdgcn_global_load_lds((const unsigned*)((const char*)(gbase) + (voff)[_i]), (PG8_LAS unsigned*)(lds + (bufoff) + ldsw + _i * 8192), 16, 0, 0); } while (0)
#define PG8_LDA(dst, b, h) do { _Pragma("unroll") for (int m = 0; m < 4; ++m) _Pragma("unroll") for (int k = 0; k < 2; ++k) dst[m][k] = *(const PG8_LAS bf16x8*)(lds + PG8_SA(b, h) + aoff + m * 2048 + k * 1024); } while (0)
#define PG8_LDB(dst, b, h) do { _Pragma("unroll") for (int n = 0; n < 2; ++n) _Pragma("unroll") for (int k = 0; k < 2; ++k) dst[n][k] = *(const PG8_LAS bf16x8*)(lds + PG8_SB(b, h) + boff + n * 2048 + k * 1024); } while (0)
#define PG8_MMA(ai, bj, At, Bt) do { __builtin_amdgcn_s_setprio(1); _Pragma("unroll") for (int m = 0; m < 4; ++m) _Pragma("unroll") for (int n = 0; n < 2; ++n) _Pragma("unroll") for (int k = 0; k < 2; ++k) \
        acc[ai][bj][m][n] = __builtin_amdgcn_mfma_f32_16x16x32_bf16(Bt[n][k], At[m][k], acc[ai][bj][m][n], 0, 0, 0); __builtin_amdgcn_s_setprio(0); } while (0)
#define PG8_WAIT_V(n) asm volatile("s_waitcnt vmcnt(" #n ")" ::: "memory")
#define PG8_WAIT_L(n) asm volatile("s_waitcnt lgkmcnt(" #n ")" ::: "memory")
#define PG8_BAR __builtin_amdgcn_s_barrier()
#define PG8_SCHED __builtin_amdgcn_sched_barrier(0)
    Unit cur, nxt; int ui = 0;
    if (!S.next(0, cur)) return;
    f32x4 acc[2][2][4][2];
#pragma unroll
    for (int a = 0; a < 2; ++a)
#pragma unroll
        for (int b = 0; b < 2; ++b)
#pragma unroll
            for (int m = 0; m < 4; ++m)
#pragma unroll
                for (int n = 0; n < 2; ++n) acc[a][b][m][n] = (f32x4){0.f, 0.f, 0.f, 0.f};
    bf16x8 At[4][2], B0[2][2], B1[2][2];
    const char* cA = (const char*)g.A + (size_t)cur.pm * tstep; const char* cB = (const char*)g.Bt + (size_t)cur.pn * tstep;
    S.a_ready(cur);
    if constexpr (SP2) {
        PG8_STAGE(PG8_SB(0, 0), cB, voffB); PG8_STAGE(PG8_SB(0, 1), cB + hstep, voffB); PG8_STAGE(PG8_SA(0, 0), cA, voffA); PG8_STAGE(PG8_SA(0, 1), cA + hstep, voffA);
        if (wr == 1) PG8_BAR;
        PG8_WAIT_V(2); PG8_BAR;
        PG8_STAGE(PG8_SB(1, 0), cB + kstep, voffB); PG8_STAGE(PG8_SA(1, 0), cA + kstep, voffA); PG8_STAGE(PG8_SB(1, 1), cB + hstep + kstep, voffB);
        PG8_WAIT_V(6); PG8_BAR;
    } else {
        PG8_STAGE(PG8_SB(0, 0), cB, voffB); PG8_STAGE(PG8_SA(0, 0), cA, voffA); PG8_STAGE(PG8_SB(0, 1), cB + hstep, voffB); PG8_STAGE(PG8_SA(0, 1), cA + hstep, voffA);
        if (wr == 1) PG8_BAR;
        PG8_WAIT_V(4); PG8_BAR;
        PG8_STAGE(PG8_SB(1, 0), cB + kstep, voffB); PG8_STAGE(PG8_SA(1, 0), cA + kstep, voffA); PG8_STAGE(PG8_SB(1, 1), cB + hstep + kstep, voffB);
        PG8_WAIT_V(6); PG8_BAR;
    }
    for (;;) {
        const bool has_next = S.next(ui + 1, nxt);
        const char* nA = has_next ? (const char*)g.A + (size_t)nxt.pm * tstep : cA; const char* nB = has_next ? (const char*)g.Bt + (size_t)nxt.pn * tstep : cB;
        for (int t = 0; t < nt; t += 2) {
            const bool last = (t == nt - 2);
            if constexpr (Epi::KHOOK) { if ((t & 7) == 0 && t != 0) E.khook(acc, cur, t >> 3, wr, fr); }
            const char* a1 = cA + (size_t)(t + 1) * kstep;
            const char* a2 = last ? nA : cA + (size_t)(t + 2) * kstep; const char* b2 = last ? nB : cB + (size_t)(t + 2) * kstep;
            const char* a3 = a2 + kstep; const char* b3 = b2 + kstep;
            if (last && has_next) S.a_ready(nxt);
            if constexpr (SP2) {
            PG8_LDB(B0, 0, 0); PG8_LDB(B1, 0, 1); PG8_SCHED; PG8_LDA(At, 0, 0); PG8_STAGE(PG8_SA(1, 1), a1 + hstep, voffA);
            PG8_WAIT_V(8); PG8_WAIT_L(0); PG8_BAR; PG8_MMA(0, 0, At, B0); PG8_MMA(0, 1, At, B1); PG8_BAR; PG8_SCHED;
            PG8_LDA(At, 0, 1); PG8_STAGE(PG8_SB(0, 0), b2, voffB); PG8_STAGE(PG8_SB(0, 1), b2 + hstep, voffB); PG8_STAGE(PG8_SA(0, 0), a2, voffA);
            PG8_WAIT_V(8); PG8_WAIT_L(0); PG8_BAR; PG8_MMA(1, 0, At, B0); PG8_MMA(1, 1, At, B1); PG8_BAR; PG8_SCHED;
            PG8_LDB(B0, 1, 0); PG8_LDB(B1, 1, 1); PG8_SCHED; PG8_LDA(At, 1, 0); PG8_STAGE(PG8_SA(0, 1), a2 + hstep, voffA);
            PG8_WAIT_V(8); PG8_WAIT_L(0); PG8_BAR; PG8_MMA(0, 0, At, B0); PG8_MMA(0, 1, At, B1); PG8_BAR; PG8_SCHED;
            PG8_LDA(At, 1, 1); PG8_STAGE(PG8_SB(1, 0), b3, voffB); PG8_STAGE(PG8_SB(1, 1), b3 + hstep, voffB); PG8_STAGE(PG8_SA(1, 0), a3, voffA);
            PG8_WAIT_V(8); PG8_WAIT_L(0); PG8_BAR; PG8_MMA(1, 0, At, B0); PG8_MMA(1, 1, At, B1); PG8_BAR; PG8_SCHED;
            } else {
            PG8_LDB(B0, 0, 0); PG8_SCHED; PG8_LDA(At, 0, 0); PG8_STAGE(PG8_SA(1, 1), a1 + hstep, voffA);
            PG8_WAIT_L(8); PG8_BAR; PG8_WAIT_L(0); PG8_MMA(0, 0, At, B0); PG8_BAR; PG8_SCHED;
            PG8_LDB(B1, 0, 1); PG8_STAGE(PG8_SB(0, 0), b2, voffB);
            PG8_BAR; PG8_WAIT_L(0); PG8_MMA(0, 1, At, B1); PG8_BAR;
            PG8_LDA(At, 0, 1); PG8_STAGE(PG8_SA(0, 0), a2, voffA);
            PG8_BAR; PG8_WAIT_L(0); PG8_MMA(1, 0, At, B0); PG8_BAR; PG8_SCHED;
            PG8_STAGE(PG8_SB(0, 1), b2 + hstep, voffB);
            PG8_WAIT_V(6); PG8_BAR; PG8_MMA(1, 1, At, B1); PG8_BAR;
            PG8_LDB(B0, 1, 0); PG8_SCHED; PG8_LDA(At, 1, 0); PG8_STAGE(PG8_SA(0, 1), a2 + hstep, voffA);
            PG8_WAIT_L(8); PG8_BAR; PG8_WAIT_L(0); PG8_MMA(0, 0, At, B0); PG8_BAR; PG8_SCHED;
            PG8_LDB(B1, 1, 1); PG8_STAGE(PG8_SB(1, 0), b3, voffB);
            PG8_BAR; PG8_WAIT_L(0); PG8_MMA(0, 1, At, B1); PG8_BAR;
            PG8_LDA(At, 1, 1); PG8_STAGE(PG8_SA(1, 0), a3, voffA);
            PG8_BAR; PG8_WAIT_L(0); PG8_MMA(1, 0, At, B0); PG8_BAR; PG8_SCHED;
            PG8_STAGE(PG8_SB(1, 1), b3 + hstep, voffB);
            PG8_WAIT_V(6); PG8_BAR; PG8_MMA(1, 1, At, B1); PG8_BAR;
            }
        }
        if constexpr (ALIGN_EPI) { if (wr == 0) PG8_BAR; }
        if constexpr (!Epi::AFTER_DRAIN) { E(acc, cur, wr, wc, fr, fq); S.done(cur); }
        if (!has_next) break;
#pragma unroll
        for (int a = 0; a < 2; ++a)
#pragma unroll
            for (int b = 0; b < 2; ++b)
#pragma unroll
                for (int m = 0; m < 4; ++m)
#pragma unroll
                    for (int n = 0; n < 2; ++n) acc[a][b][m][n] = (f32x4){0.f, 0.f, 0.f, 0.f};
        cur = nxt; cA = nA; cB = nB; ++ui;
        if constexpr (ALIGN_EPI) { if (wr == 1) PG8_BAR; }
    }
    PG8_WAIT_V(0);
    if constexpr (!ALIGN_EPI) { if (wr == 0) PG8_BAR; }
    PG8_BAR;
    if constexpr (Epi::AFTER_DRAIN) { E.fused(acc, cur, wr, wc, fr, fq, lds, wid, lane); S.done(cur); }
#undef PG8_SA
#undef PG8_SB
#undef PG8_STAGE
#undef PG8_LDA
#undef PG8_LDB
#undef PG8_MMA
#undef PG8_WAIT_V
#undef PG8_WAIT_L
#undef PG8_BAR
#undef PG8_SCHED
}
}
namespace att {
typedef short v4i16_t __attribute__((ext_vector_type(4)));
constexpr int KV_BUF = 32768, V_OFF = 16384, XCH_OFF = 65536, STG_PITCH = 272;
__device__ __forceinline__ bf16x8 ldsK(const LAS unsigned char* kb, int row, int chunk) { return *(const LAS bf16x8*)(kb + row * 128 + ((chunk ^ ((row >> 1) & 7)) << 4)); }
__device__ __forceinline__ unsigned cvtpk(float lo, float hi) { typedef float f2 __attribute__((ext_vector_type(2))); typedef __bf16 b2 __attribute__((ext_vector_type(2))); f2 v = {lo, hi}; b2 b = __builtin_convertvector(v, b2); return __builtin_bit_cast(unsigned, b); }
__device__ __forceinline__ u32x4 cvt8(f32x4 a, f32x4 b) { u32x4 w; w.x = cvtpk(a[0], a[1]); w.y = cvtpk(a[2], a[3]); w.z = cvtpk(b[0], b[1]); w.w = cvtpk(b[2], b[3]); return w; }

struct State { f32x16 o[4]; float m, l; };

template <bool TAIL16>
__device__ __forceinline__ void tile_step(State& st, const LAS unsigned char* kb, const LAS unsigned char* vb, const bf16x8 (&qf)[4]) {
    const int lane = fresh_lane(), r32 = lane & 31, hi = lane >> 5;
    const LAS unsigned char* ka[4];
#pragma unroll
    for (int ks = 0; ks < 4; ++ks) ka[ks] = kb + r32 * 128 + (((2 * ks + hi) ^ ((r32 >> 1) & 7)) << 4);
    f32x16 p[2];
#pragma unroll
    for (int blk = 0; blk < 2; ++blk) {
        p[blk] = (f32x16){0.f, 0.f, 0.f, 0.f, 0.f, 0.f, 0.f, 0.f, 0.f, 0.f, 0.f, 0.f, 0.f, 0.f, 0.f, 0.f};
#pragma unroll
        for (int ks = 0; ks < 4; ++ks) p[blk] = __builtin_amdgcn_mfma_f32_32x32x16_bf16(*(const LAS bf16x8*)(ka[ks] + blk * 4096), qf[ks], p[blk], 0, 0, 0);
    }
    if (TAIL16) {
#pragma unroll
        for (int i = 8; i < 16; ++i) p[0][i] = -1e30f;
#pragma unroll
        for (int i = 0; i < 16; ++i) p[1][i] = -1e30f;
    }
    float mt = p[0][0];
#pragma unroll
    for (int i = 1; i < 16; ++i) mt = fmaxf(mt, p[0][i]);
#pragma unroll
    for (int i = 0; i < 16; ++i) mt = fmaxf(mt, p[1][i]);
    mt = fmaxf(mt, __shfl_xor(mt, 32));
    const float mn = fmaxf(st.m, mt);
    if (__any(mn > st.m)) {
        const float alpha = __builtin_amdgcn_exp2f(st.m - mn); st.l *= alpha;
#pragma unroll
        for (int c = 0; c < 4; ++c)
#pragma unroll
            for (int i = 0; i < 16; ++i) st.o[c][i] *= alpha;
        st.m = mn;
    }
    float ls = 0.f;
#pragma unroll
    for (int blk = 0; blk < 2; ++blk)
#pragma unroll
        for (int i = 0; i < 16; ++i) { p[blk][i] = __builtin_amdgcn_exp2f(p[blk][i] - st.m); ls += p[blk][i]; }
    st.l += ls;
    bf16x8 pb[4];
#pragma unroll
    for (int kk = 0; kk < 4; ++kk) { const int blk = kk >> 1, s2 = kk & 1; u32x4 w;
        w.x = cvtpk(p[blk][8 * s2 + 0], p[blk][8 * s2 + 1]); w.y = cvtpk(p[blk][8 * s2 + 2], p[blk][8 * s2 + 3]); w.z = cvtpk(p[blk][8 * s2 + 4], p[blk][8 * s2 + 5]); w.w = cvtpk(p[blk][8 * s2 + 6], p[blk][8 * s2 + 7]);
        pb[kk] = __builtin_bit_cast(bf16x8, w); }
    const int q4 = (lane & 15) >> 2, pp = lane & 3, blkv = (lane >> 4) & 1;
    const LAS unsigned char* va[4];
#pragma unroll
    for (int c = 0; c < 4; ++c) va[c] = vb + (4 * hi + q4) * 256 + (((4 * c + 2 * blkv + (pp >> 1)) ^ (q4 << 2)) << 4) + ((pp & 1) << 3);
#pragma unroll
    for (int kk = 0; kk < (TAIL16 ? 1 : 4); ++kk) {
#pragma unroll
        for (int c = 0; c < 4; ++c) {
            const v4i16_t lo = __builtin_amdgcn_ds_read_tr16_b64_v4i16((LAS v4i16_t*)(va[c] + (16 * kk) * 256));
            const v4i16_t hh = __builtin_amdgcn_ds_read_tr16_b64_v4i16((LAS v4i16_t*)(va[c] + (16 * kk + 8) * 256));
            const bf16x8 vf = {lo[0], lo[1], lo[2], lo[3], hh[0], hh[1], hh[2], hh[3]};
            st.o[c] = __builtin_amdgcn_mfma_f32_32x32x16_bf16(vf, pb[kk], st.o[c], 0, 0, 0);
        }
    }
}

struct Stage { u32x4 k[2], v[2]; };
__device__ __forceinline__ void stage_store(LAS unsigned char* buf, const Stage& s, int wave) {
    const int tid = wave * 64 + fresh_lane();
#pragma unroll
    for (int i = 0; i < 2; ++i) { const int id = tid + 512 * i, r = id >> 4, c16 = id & 15;
        *(LAS u32x4*)(buf + (c16 >> 3) * 8192 + r * 128 + (((c16 & 7) ^ ((r >> 1) & 7)) << 4)) = s.k[i];
        *(LAS u32x4*)(buf + V_OFF + r * 256 + ((c16 ^ ((r & 3) << 2)) << 4)) = s.v[i]; }
}
__device__ __forceinline__ void stage_load_bf16(Stage& s, const bf16_t* K, const bf16_t* V, size_t row0, int h, int wave, int nvalid) {
    const int tid = wave * 64 + fresh_lane();
#pragma unroll
    for (int i = 0; i < 2; ++i) { const int id = tid + 512 * i, r = id >> 4, c16 = id & 15; const size_t off = (row0 + r) * DM + h * 128 + c16 * 8;
        if (r < nvalid) { s.k[i] = *(const u32x4*)(K + off); s.v[i] = *(const u32x4*)(V + off); } else { s.k[i] = (u32x4){0u, 0u, 0u, 0u}; s.v[i] = (u32x4){0u, 0u, 0u, 0u}; } }
}
struct StageF { f32x4 k[2][2], v[2][2]; };
__device__ __forceinline__ void stage_load_f32(StageF& s, const float* K, const float* V, size_t row0, int h, int wave) {
    const int tid = wave * 64 + fresh_lane();
#pragma unroll
    for (int i = 0; i < 2; ++i) { const int id = tid + 512 * i, r = id >> 4, c16 = id & 15; const size_t off = (row0 + r) * DM + h * 128 + c16 * 8;
        s.k[i][0] = *(const f32x4*)(K + off); s.k[i][1] = *(const f32x4*)(K + off + 4); s.v[i][0] = *(const f32x4*)(V + off); s.v[i][1] = *(const f32x4*)(V + off + 4); }
}
__device__ __forceinline__ void stage_cvt(Stage& d, const StageF& s) {
#pragma unroll
    for (int i = 0; i < 2; ++i) { d.k[i] = cvt8(s.k[i][0], s.k[i][1]); d.v[i] = cvt8(s.v[i][0], s.v[i][1]); }
}

__device__ __forceinline__ void unit_epilogue(State& st, LAS unsigned char* L, const Ptrs& P, size_t urow0, int h, int nrows, float lam, int wave) {
    const int lane = fresh_lane(), tid = wave * 64 + lane, rg = wave >> 1, s = wave & 1, r32 = lane & 31, hi = lane >> 5;
    const float lt = st.l + __shfl_xor(st.l, 32); const float inv = 1.0f / lt;
    LAS float* xch = (LAS float*)(L + XCH_OFF) + rg * 4096;
    if (s == 1) {
        const float f = inv * lam;
#pragma unroll
        for (int c = 0; c < 4; ++c)
#pragma unroll
            for (int i = 0; i < 16; ++i) xch[(c * 16 + i) * 64 + lane] = st.o[c][i] * f;
    }
    __syncthreads();
    if (s == 0) {
        float ssq = 0.f;
#pragma unroll
        for (int c = 0; c < 4; ++c)
#pragma unroll
            for (int i = 0; i < 16; ++i) { const float d = st.o[c][i] * inv - xch[(c * 16 + i) * 64 + lane]; st.o[c][i] = d; ssq += d * d; }
        ssq += __shfl_xor(ssq, 32);
        const float r = (1.0f - LAMBDA_INIT) / sqrtf(ssq * (1.f / 128.f) + SUBLN_EPS);
        LAS unsigned char* stg = L + (rg * 32 + r32) * STG_PITCH;
#pragma unroll
        for (int c = 0; c < 4; ++c)
#pragma unroll
            for (int g = 0; g < 4; ++g) { const int dv = 32 * c + 8 * g + 4 * hi; const f32x4 w = *(const f32x4*)(P.subln + dv);
                u32x2 o; o.x = cvtpk(st.o[c][4 * g] * r * w[0], st.o[c][4 * g + 1] * r * w[1]); o.y = cvtpk(st.o[c][4 * g + 2] * r * w[2], st.o[c][4 * g + 3] * r * w[3]);
                *(LAS u32x2*)(stg + dv * 2) = o; }
    }
    __syncthreads();
    const bf16_t* G0 = (const bf16_t*)(P.ws + WS_G0); bf16_t* O0 = (bf16_t*)(P.ws + WS_XN0);
#pragma unroll
    for (int i = 0; i < 4; ++i) { const int id = tid + 512 * i, row = id >> 4, ch = id & 15;
        if (row < nrows) { const u32x4 v = *(const LAS u32x4*)(L + row * STG_PITCH + ch * 16); const size_t off = (urow0 + row) * DM + h * 128 + ch * 8; const u32x4 g = *(const u32x4*)(G0 + off);
            u32x4 o;
#pragma unroll
            for (int j = 0; j < 4; ++j) { const float a0 = __builtin_bit_cast(float, v[j] << 16) * __builtin_bit_cast(float, g[j] << 16), a1 = __builtin_bit_cast(float, v[j] & 0xffff0000u) * __builtin_bit_cast(float, g[j] & 0xffff0000u); o[j] = cvtpk(a0, a1); }
            *(u32x4*)(O0 + off) = o; } }
    __syncthreads();
}

__device__ __forceinline__ void attn_phase(const Ptrs& P, unsigned char* lds, int vcu, int G) {
    LAS unsigned char* L = (LAS unsigned char*)lds;
    const int tid = threadIdx.x, lane = tid & 63, wave = __builtin_amdgcn_readfirstlane(tid >> 6), rg = wave >> 1, s = wave & 1, r32 = lane & 31, hi = lane >> 5;
    const bf16_t* Q0 = (const bf16_t*)(P.ws + WS_Q0); const bf16_t* K0 = (const bf16_t*)(P.ws + WS_K0); const bf16_t* V0 = (const bf16_t*)(P.ws + WS_V0);
    const float lam = *(const float*)(P.ws + WS_LAM);
    for (int bh = vcu; bh < NB * 16; bh += G) {
        const int b = bh >> 4, h = bh & 15;
        for (int qb = 15; qb >= 0; --qb) {
            const size_t urow0 = (size_t)b * SEQ + qb * 128, qrow = urow0 + rg * 32 + r32;
            bf16x8 qf[4];
#pragma unroll
            for (int ks = 0; ks < 4; ++ks) qf[ks] = *(const bf16x8*)(Q0 + qrow * DM + h * 128 + s * 64 + ks * 16 + hi * 8);
            State st; st.m = -1e30f; st.l = 0.f;
#pragma unroll
            for (int c = 0; c < 4; ++c) st.o[c] = (f32x16){0.f, 0.f, 0.f, 0.f, 0.f, 0.f, 0.f, 0.f, 0.f, 0.f, 0.f, 0.f, 0.f, 0.f, 0.f, 0.f};
            const int NT = 2 * qb + 2, NTW = 2 * qb + 1 + (rg >> 1);
            Stage sg; stage_load_bf16(sg, K0, V0, (size_t)b * SEQ, h, wave, 64); stage_store(L, sg, wave); __syncthreads();
            for (int t = 0; t < NT; ++t) {
                if (t + 1 < NT) stage_load_bf16(sg, K0, V0, (size_t)b * SEQ + (size_t)(t + 1) * 64, h, wave, 64);
                const LAS unsigned char* buf = L + (t & 1) * KV_BUF;
                if (t < NTW) tile_step<false>(st, buf + s * 8192, buf + V_OFF, qf);
                if (t + 1 < NT) stage_store(L + ((t + 1) & 1) * KV_BUF, sg, wave);
                __syncthreads();
            }
            unit_epilogue(st, L, P, urow0, h, 128, lam, wave);
        }
        {
            const size_t urow0 = (size_t)MP + b * DSEQ, qrow = urow0 + (r32 & 15);
            bf16x8 qf[4];
#pragma unroll
            for (int ks = 0; ks < 4; ++ks) qf[ks] = *(const bf16x8*)(Q0 + qrow * DM + h * 128 + s * 64 + ks * 16 + hi * 8);
            State st; st.m = -1e30f; st.l = 0.f;
#pragma unroll
            for (int c = 0; c < 4; ++c) st.o[c] = (f32x16){0.f, 0.f, 0.f, 0.f, 0.f, 0.f, 0.f, 0.f, 0.f, 0.f, 0.f, 0.f, 0.f, 0.f, 0.f, 0.f};
            constexpr int NT = PAST / 64 + 1;
            Stage sg; StageF sf;
            stage_load_f32(sf, P.ck, P.cv, (size_t)b * PAST, h, wave); stage_cvt(sg, sf); stage_store(L, sg, wave); __syncthreads();
            for (int t = 0; t < NT; ++t) {
                if (t + 1 < NT - 1) stage_load_f32(sf, P.ck, P.cv, (size_t)b * PAST + (size_t)(t + 1) * 64, h, wave);
                else if (t + 1 == NT - 1) stage_load_bf16(sg, K0, V0, urow0, h, wave, DSEQ);
                const LAS unsigned char* buf = L + (t & 1) * KV_BUF;
                if (rg == 0) { if (t < NT - 1) tile_step<false>(st, buf + s * 8192, buf + V_OFF, qf); else tile_step<true>(st, buf + s * 8192, buf + V_OFF, qf); }
                if (t + 1 < NT - 1) stage_cvt(sg, sf);
                if (t + 1 < NT) stage_store(L + ((t + 1) & 1) * KV_BUF, sg, wave);
                __syncthreads();
            }
            unit_epilogue(st, L, P, urow0, h, DSEQ, lam, wave);
        }
    }
}
}
using att::attn_phase;
namespace ret {
typedef short v4i16_t __attribute__((ext_vector_type(4)));
constexpr int Q_OFF = 0, K_OFF = 32768, V_OFF = 65536, SC_OFF = 98304;
__device__ __forceinline__ int swz(int row) { return ((row & 3) << 2) | ((row >> 2) & 3); }
__device__ __forceinline__ unsigned cvtpk(float lo, float hi) { typedef float f2 __attribute__((ext_vector_type(2))); typedef __bf16 b2 __attribute__((ext_vector_type(2))); f2 v = {lo, hi}; b2 b = __builtin_convertvector(v, b2); return __builtin_bit_cast(unsigned, b); }
__device__ __forceinline__ float bflo(unsigned u) { return __builtin_bit_cast(float, u << 16); }
__device__ __forceinline__ float bfhi(unsigned u) { return __builtin_bit_cast(float, u & 0xffff0000u); }

__device__ __forceinline__ void stage_tile(LAS unsigned char* dst, const bf16_t* src, size_t ld, int L, int wave) {
    const int tid = wave * 64 + fresh_lane();
    u32x4 v[4];
#pragma unroll
    for (int i = 0; i < 4; ++i) { const int id = tid + 512 * i, row = id >> 5, ch = id & 31;
        v[i] = row < L ? *(const u32x4*)(src + (size_t)row * ld + ch * 8) : (u32x4){0u, 0u, 0u, 0u}; }
#pragma unroll
    for (int i = 0; i < 4; ++i) { const int id = tid + 512 * i, row = id >> 5, ch = id & 31;
        *(LAS u32x4*)(dst + row * 512 + ((ch ^ swz(row)) << 4)) = v[i]; }
}

__device__ __forceinline__ void ret_unit(const Ptrs& P, LAS unsigned char* L_, int b, int h, int e, bool smp, int wave) {
    const bf16_t* Qr = (const bf16_t*)(P.ws + WS_XN0); const bf16_t* Kr = (const bf16_t*)(P.ws + WS_K0); const bf16_t* Vr = (const bf16_t*)(P.ws + WS_V0); bf16_t* Gr = (bf16_t*)(P.ws + WS_GR);
    float* ssqR = (float*)(P.ws + WS_SSQR);
    const int nch = smp ? 1 : SEQ / 64, L = smp ? DSEQ : 64; const size_t row0 = smp ? (size_t)MP + (size_t)b * DSEQ : (size_t)b * SEQ;
    const float lg2 = log1pf(-exp2f(-5.0f - (float)h)) * 1.4426950408889634f;
    const float cd = exp2f(lg2 * (float)L);
    f32x16 S[8];
    const size_t st_off = (((size_t)b * 8 + h) * 256) * 512 + e * 256 + wave * 32;
    { const int lane = fresh_lane(), r32 = lane & 31, hi = lane >> 5;
#pragma unroll
      for (int kb = 0; kb < 8; ++kb)
#pragma unroll
          for (int i = 0; i < 16; ++i) S[kb][i] = smp ? P.st[st_off + (size_t)(32 * kb + (i & 3) + 8 * (i >> 2) + 4 * hi) * 512 + r32] : 0.f; }
    for (int c = 0; c < nch; ++c) {
        const size_t r0 = row0 + (size_t)c * 64;
        stage_tile(L_ + Q_OFF, Qr + r0 * DM + h * 256, DM, L, wave);
        stage_tile(L_ + K_OFF, Kr + r0 * DM + h * 256, DM, L, wave);
        stage_tile(L_ + V_OFF, Vr + r0 * BV + h * 512 + e * 256, BV, L, wave);
        __syncthreads();
        {
            const int lane = fresh_lane(), l15 = lane & 15, g = lane >> 4, tq = 16 * (wave >> 1) + l15;
            f32x4 a0 = {0.f, 0.f, 0.f, 0.f}, a1 = a0;
            const int tk_a = 32 * (wave & 1) + l15, tk_b = tk_a + 16;
#pragma unroll
            for (int ks = 0; ks < 8; ++ks) { const int ch = 4 * ks + g;
                const bf16x8 qf = *(const LAS bf16x8*)(L_ + Q_OFF + tq * 512 + ((ch ^ swz(tq)) << 4));
                const bf16x8 k0 = *(const LAS bf16x8*)(L_ + K_OFF + tk_a * 512 + ((ch ^ swz(tk_a)) << 4));
                const bf16x8 k1 = *(const LAS bf16x8*)(L_ + K_OFF + tk_b * 512 + ((ch ^ swz(tk_b)) << 4));
                a0 = __builtin_amdgcn_mfma_f32_16x16x32_bf16(k0, qf, a0, 0, 0, 0); a1 = __builtin_amdgcn_mfma_f32_16x16x32_bf16(k1, qf, a1, 0, 0, 0);
                if (ks & 1) __builtin_amdgcn_sched_barrier(0); }
#pragma unroll
            for (int blk = 0; blk < 2; ++blk) { const f32x4 a = blk ? a1 : a0; const int tk0 = 32 * (wave & 1) + 16 * blk + 4 * g; float d[4];
#pragma unroll
                for (int j = 0; j < 4; ++j) d[j] = a[j] * exp2f(lg2 * fabsf((float)(tq - (tk0 + j))));
                u32x2 o; o.x = cvtpk(d[0], d[1]); o.y = cvtpk(d[2], d[3]);
                *(LAS u32x2*)(L_ + SC_OFF + tq * 128 + ((((tk0 >> 3)) ^ ((tq >> 1) & 7)) << 4) + ((tk0 >> 2) & 1) * 8) = o; }
        }
        f32x16 y[2];
        y[0] = (f32x16){0.f, 0.f, 0.f, 0.f, 0.f, 0.f, 0.f, 0.f, 0.f, 0.f, 0.f, 0.f, 0.f, 0.f, 0.f, 0.f}; y[1] = y[0];
        {
            const int lane = fresh_lane(), r32 = lane & 31, hi = lane >> 5;
#pragma unroll
            for (int kb = 0; kb < 8; ++kb)
#pragma unroll
                for (int s = 0; s < 2; ++s) {
                    u32x4 w; w.x = cvtpk(S[kb][8 * s + 0], S[kb][8 * s + 1]); w.y = cvtpk(S[kb][8 * s + 2], S[kb][8 * s + 3]); w.z = cvtpk(S[kb][8 * s + 4], S[kb][8 * s + 5]); w.w = cvtpk(S[kb][8 * s + 6], S[kb][8 * s + 7]);
                    const bf16x8 sb = __builtin_bit_cast(bf16x8, w);
#pragma unroll
                    for (int tqb = 0; tqb < 2; ++tqb) { const int row = 32 * tqb + r32, ch = 4 * kb + 2 * s; const LAS unsigned char* rp = L_ + Q_OFF + row * 512 + 8 * hi;
                        const u32x2 lo = *(const LAS u32x2*)(rp + ((ch ^ swz(row)) << 4)), hh = *(const LAS u32x2*)(rp + (((ch + 1) ^ swz(row)) << 4));
                        const u32x4 qa = {lo.x, lo.y, hh.x, hh.y};
                        y[tqb] = __builtin_amdgcn_mfma_f32_32x32x16_bf16(__builtin_bit_cast(bf16x8, qa), sb, y[tqb], 0, 0, 0); }
                    __builtin_amdgcn_sched_barrier(0);
                }
#pragma unroll
            for (int tqb = 0; tqb < 2; ++tqb)
#pragma unroll
                for (int i = 0; i < 16; ++i) y[tqb][i] *= exp2f(lg2 * (float)(32 * tqb + (i & 3) + 8 * (i >> 2) + 4 * hi + 1));
        }
        __syncthreads();
        {
            const int lane = fresh_lane(), r32 = lane & 31, hi = lane >> 5, q4 = (lane & 15) >> 2, pp = lane & 3, blkv = (lane >> 4) & 1;
            bf16x8 vf[4];
#pragma unroll
            for (int ks = 0; ks < 4; ++ks) { v4i16_t t0, t1;
                { const int row = 16 * ks + 8 * hi + q4, ch = 4 * wave + 2 * blkv + (pp >> 1); t0 = __builtin_amdgcn_ds_read_tr16_b64_v4i16((LAS v4i16_t*)(L_ + V_OFF + row * 512 + ((ch ^ swz(row)) << 4) + ((pp & 1) << 3))); }
                { const int row = 16 * ks + 8 * hi + 4 + q4, ch = 4 * wave + 2 * blkv + (pp >> 1); t1 = __builtin_amdgcn_ds_read_tr16_b64_v4i16((LAS v4i16_t*)(L_ + V_OFF + row * 512 + ((ch ^ swz(row)) << 4) + ((pp & 1) << 3))); }
                vf[ks] = (bf16x8){t0[0], t0[1], t0[2], t0[3], t1[0], t1[1], t1[2], t1[3]}; }
#pragma unroll
            for (int tqb = 0; tqb < 2; ++tqb)
#pragma unroll
                for (int ks = 0; ks < 4; ++ks) { const int row = 32 * tqb + r32, ch = 2 * ks + hi;
                    const bf16x8 sa = *(const LAS bf16x8*)(L_ + SC_OFF + row * 128 + ((ch ^ ((row >> 1) & 7)) << 4));
                    y[tqb] = __builtin_amdgcn_mfma_f32_32x32x16_bf16(sa, vf[ks], y[tqb], 0, 0, 0); }
#pragma unroll
            for (int tqb = 0; tqb < 2; ++tqb)
#pragma unroll
                for (int i = 0; i < 16; ++i) { const int tq = 32 * tqb + (i & 3) + 8 * (i >> 2) + 4 * hi;
                    *(LAS unsigned short*)(L_ + Q_OFF + tq * 512 + (32 * wave + r32) * 2) = (unsigned short)(cvtpk(y[tqb][i], 0.f) & 0xffffu); }
#pragma unroll
            for (int ks = 0; ks < 4; ++ks) { u32x4 w = __builtin_bit_cast(u32x4, vf[ks]);
#pragma unroll
                for (int j = 0; j < 4; ++j) { const float d0 = exp2f(lg2 * (float)(L - 1 - (16 * ks + 8 * hi + 2 * j))), d1 = exp2f(lg2 * (float)(L - 2 - (16 * ks + 8 * hi + 2 * j)));
                    w[j] = cvtpk(bflo(w[j]) * d0, bfhi(w[j]) * d1); }
                vf[ks] = __builtin_bit_cast(bf16x8, w); }
#pragma unroll
            for (int kb = 0; kb < 8; ++kb) {
#pragma unroll
                for (int i = 0; i < 16; ++i) S[kb][i] *= cd;
#pragma unroll
                for (int ks = 0; ks < 4; ++ks) { v4i16_t t0, t1;
                    { const int row = 16 * ks + 8 * hi + q4, ch = 4 * kb + 2 * blkv + (pp >> 1); t0 = __builtin_amdgcn_ds_read_tr16_b64_v4i16((LAS v4i16_t*)(L_ + K_OFF + row * 512 + ((ch ^ swz(row)) << 4) + ((pp & 1) << 3))); }
                    { const int row = 16 * ks + 8 * hi + 4 + q4, ch = 4 * kb + 2 * blkv + (pp >> 1); t1 = __builtin_amdgcn_ds_read_tr16_b64_v4i16((LAS v4i16_t*)(L_ + K_OFF + row * 512 + ((ch ^ swz(row)) << 4) + ((pp & 1) << 3))); }
                    const bf16x8 kt = {t0[0], t0[1], t0[2], t0[3], t1[0], t1[1], t1[2], t1[3]};
                    S[kb] = __builtin_amdgcn_mfma_f32_32x32x16_bf16(kt, vf[ks], S[kb], 0, 0, 0); }
                __builtin_amdgcn_sched_barrier(0);
            }
        }
        __syncthreads();
        {
            const int tid = wave * 64 + fresh_lane();
#pragma unroll
            for (int i = 0; i < 4; ++i) { const int id = tid + 512 * i, row = id >> 5, ch = id & 31;
                const u32x4 v = *(const LAS u32x4*)(L_ + Q_OFF + row * 512 + ch * 16);
                float f[8]; float q = 0.f;
#pragma unroll
                for (int j = 0; j < 4; ++j) { f[2 * j] = bflo(v[j]); f[2 * j + 1] = bfhi(v[j]); q += f[2 * j] * f[2 * j] + f[2 * j + 1] * f[2 * j + 1]; }
                q += __shfl_xor(q, 1); q += __shfl_xor(q, 2); q += __shfl_xor(q, 4); q += __shfl_xor(q, 8); q += __shfl_xor(q, 16);
                if (row < L) { bf16_t* gp = Gr + (r0 + row) * BV + h * 512 + e * 256 + ch * 8; const u32x4 g = *(const u32x4*)gp; u32x4 o;
#pragma unroll
                    for (int j = 0; j < 4; ++j) o[j] = cvtpk(f[2 * j] * bflo(g[j]), f[2 * j + 1] * bfhi(g[j]));
                    *(u32x4*)gp = o;
                    if (ch == 0) ssqR[(r0 + row) * 16 + h * 2 + e] = q; }
            }
        }
        __syncthreads();
    }
    { const int lane = fresh_lane(), r32 = lane & 31, hi = lane >> 5; float* so = P.out + (smp ? OUT_ST_S : OUT_ST_P) + st_off;
#pragma unroll
      for (int kb = 0; kb < 8; ++kb)
#pragma unroll
          for (int i = 0; i < 16; ++i) so[(size_t)(32 * kb + (i & 3) + 8 * (i >> 2) + 4 * hi) * 512 + r32] = S[kb][i]; }
}

__device__ __forceinline__ void ret_phase(const Ptrs& P, unsigned char* lds, int vcu, int G) {
    LAS unsigned char* L_ = (LAS unsigned char*)lds;
    const int wave = __builtin_amdgcn_readfirstlane(threadIdx.x >> 6);
    for (int u = vcu; u < 256; u += G) { const int b = u >> 4, h = (u >> 1) & 7, e = u & 1;
        ret_unit(P, L_, b, h, e, false, wave);
        ret_unit(P, L_, b, h, e, true, wave); }
}
}
using ret::ret_phase;
#ifndef HAVE_ATT
#define HAVE_ATT 0
#endif
#ifndef HAVE_RET
#define HAVE_RET 0
#endif
#ifndef PH_MASK
#define PH_MASK 0xFF
#endif
#define PH_EN(k) (((PH_MASK) >> (k)) & 1)
struct Args { Ptrs P; int ph_lo, ph_hi; };
__global__ void __launch_bounds__(NWAVES * 64, 2) mega(Args args) {
    extern __shared__ __attribute__((aligned(16))) unsigned char lds[];
    const Ptrs& P = args.P;
    const int tid = threadIdx.x, lane = tid & 63, wave = __builtin_amdgcn_readfirstlane(tid >> 6);
    const int G = gridDim.x, bx = blockIdx.x, vcu = (G % 8 == 0) ? (bx % 8) * (G / 8) + bx / 8 : bx;
    LAS unsigned char* L = (LAS unsigned char*)lds;
    volatile LAS unsigned* MISC = (volatile LAS unsigned*)(L + MISC_OFF);
    for (int u = tid; u < (LDS_BYTES - RING_BYTES) / 4; u += NWAVES * 64) ((LAS unsigned*)(L + RING_BYTES))[u] = 0u;
    __syncthreads();
    const int lo = args.ph_lo, hi = args.ph_hi;
    const bool multi = hi - lo > 1;
    XcdBarrier bar; bar.bar = (unsigned*)(P.ws + WS_CTL) + CW_BAR; bar.x = 0; bar.st = nullptr;
    if (multi) bar = xcd_barrier_post((unsigned*)(P.ws + WS_CTL) + CW_BAR, MISC + 8);
#define IN(k) (lo <= (k) && (k) < hi)
#define BOTH(k) (IN(k) && IN((k) + 1))
    const int gw = vcu * NWAVES + wave, ngw = G * NWAVES;
    unsigned char* ws = P.ws;
    bf16_t* XN0 = (bf16_t*)(ws + WS_XN0); bf16_t* Q0 = (bf16_t*)(ws + WS_Q0); bf16_t* K0 = (bf16_t*)(ws + WS_K0); bf16_t* V0 = (bf16_t*)(ws + WS_V0); bf16_t* GR = (bf16_t*)(ws + WS_GR);
    if (IN(0)) { p0_prologue(P, (LAS float*)(L + wave * 16384), gw, ngw, lane); if (BOTH(0)) xcd_barrier(bar); }
    if (PH_EN(1) && IN(1)) {
        pg8::Gemm g{XN0, (const bf16_t*)(ws + WS_WINA), MT, NA_IN, DM}; pg8::StaticOrder S; S.init(MT, NA_IN, G, bx);
        pg8::EpiA1 E{Q0, P.out, (const float*)(ws + WS_ROPE), (const float*)(ws + WS_ROPE) + 2048 * 8};
        pg8::gemm_phase<pg8::EpiA1, pg8::StaticOrder, true, true>(L, g, S, E);
        if (BOTH(1)) xcd_barrier(bar);
    }
#if HAVE_ATT
    if (IN(2)) { attn_phase(P, lds, vcu, G); if (BOTH(2)) xcd_barrier(bar); }
#endif
    if (PH_EN(3) && IN(3)) {
        pg8::Gemm g{XN0, (const bf16_t*)(ws + WS_WOUTA), MT, DM, DM}; pg8::StaticOrder S; S.init(MT, DM, G, bx);
        pg8::EpiA2 E{P.x_p, P.x_s, P.out, Q0, (float*)(ws + WS_SSQ1)};
        pg8::gemm_phase<pg8::EpiA2, pg8::StaticOrder, true, true>(L, g, S, E);
        if (BOTH(3)) xcd_barrier(bar);
    }
    if (PH_EN(4) && IN(4)) {
        pg8::Gemm g{Q0, (const bf16_t*)(ws + WS_WINB), MT, NB_IN, DM}; pg8::StaticOrder S; S.init(MT, NB_IN, G, bx);
        pg8::EpiB1 E{XN0, K0, V0, GR, (const float*)(ws + WS_SSQ1), (const float*)(ws + WS_XPOS), (const float*)(ws + WS_XPOS) + 2048 * 128};
        pg8::gemm_phase<pg8::EpiB1, pg8::StaticOrder, true, true>(L, g, S, E);
        if (BOTH(4)) xcd_barrier(bar);
    }
#if HAVE_RET
    if (IN(5)) { ret_phase(P, lds, vcu, G); if (BOTH(5)) xcd_barrier(bar); }
#endif
    if (PH_EN(6) && IN(6)) {
        pg8::Gemm g{GR, (const bf16_t*)(ws + WS_WOUTB), MT, DM, BV}; pg8::StaticOrder S; S.init(MT, DM, G, bx);
        pg8::EpiB2 E{P.out, (const float*)(ws + WS_SSQR)};
        pg8::gemm_phase<pg8::EpiB2, pg8::StaticOrder, true, true>(L, g, S, E);
        if (BOTH(6)) xcd_barrier(bar);
    }
    if (IN(7)) { p7_final(P, gw, ngw, fresh_lane()); }
#undef IN
#undef BOTH
}
#ifndef FAST_MASK
#define FAST_MASK 0
#endif
extern "C" void kernel_launch(void* const* d_in, const int* in_sizes, int n_in, void* d_out, int out_size, void* d_ws, size_t ws_size, hipStream_t stream) {
    static int grid = 0;
    if (grid == 0) {
        if (n_in != 17 || (size_t)out_size != OUT_TOTAL || ws_size < WS_END) { fprintf(stderr, "kernel_launch: unexpected sizes n_in %d out %d ws %zu (need %zu)\n", n_in, out_size, ws_size, (size_t)WS_END); grid = -1; return; }
        int dev = 0, cus = 0;
        if (hipGetDevice(&dev) != hipSuccess || hipDeviceGetAttribute(&cus, hipDeviceAttributeMultiprocessorCount, dev) != hipSuccess) { grid = -1; return; }
        if (hipFuncSetAttribute((const void*)mega, hipFuncAttributeMaxDynamicSharedMemorySize, LDS_BYTES) != hipSuccess) { fprintf(stderr, "kernel_launch: hipFuncSetAttribute failed\n"); grid = -1; return; }
        int per_cu = 0;
        if (hipOccupancyMaxActiveBlocksPerMultiprocessor(&per_cu, (const void*)mega, NWAVES * 64, LDS_BYTES) != hipSuccess || per_cu < 1) fprintf(stderr, "kernel_launch: occupancy query says %d\n", per_cu);
        (void)hipGetLastError();
        grid = cus;
    }
    if (grid < 0) return;
    Args a{};
    const float** pp = (const float**)&a.P;
    for (int i = 0; i < 17; ++i) pp[i] = (const float*)d_in[i];
    a.P.out = (float*)d_out; a.P.ws = (unsigned char*)d_ws;
    const Ptrs& P = a.P; unsigned char* ws = a.P.ws;
    hipMemsetAsync(ws + WS_CTL, 0, CTL_ZERO_BYTES, stream);
    auto run = [&](int lo, int hi) { a.ph_lo = lo; a.ph_hi = hi; hipLaunchKernelGGL(mega, dim3(grid), dim3(NWAVES * 64), LDS_BYTES, stream, a); };
#if FAST_MASK == 0xFF
    run(0, 8);
#else
    bf16_t* XN0 = (bf16_t*)(ws + WS_XN0); bf16_t* Q0 = (bf16_t*)(ws + WS_Q0); bf16_t* K0 = (bf16_t*)(ws + WS_K0); bf16_t* V0 = (bf16_t*)(ws + WS_V0); bf16_t* GR = (bf16_t*)(ws + WS_GR);
    run(0, 1);
    if (FAST_MASK & 2) run(1, 2);
    else { { orc::ERaw e{Q0, 2048, 2048, ACT / 2, nullptr}; hipLaunchKernelGGL(orc::s_gemm<orc::ERaw>, dim3(NA_IN / 64, MT / 64), dim3(256), 0, stream, XN0, (const bf16_t*)(ws + WS_WINA), DM, e); }
        hipLaunchKernelGGL(orc::s_post1, dim3((unsigned)(((size_t)MT * NA_IN + 255) / 256)), dim3(256), 0, stream, P); }
    if (FAST_MASK & 4) run(2, 3);
    else { hipLaunchKernelGGL(orc::s_attn, dim3(MP, 16), dim3(128), 0, stream, P, 0); hipLaunchKernelGGL(orc::s_attn, dim3(MS, 16), dim3(128), 0, stream, P, 1); }
    if (FAST_MASK & 8) run(3, 4);
    else { { orc::ERes1 e{P.x_p, P.x_s, P.out, Q0}; hipLaunchKernelGGL(orc::s_gemm<orc::ERes1>, dim3(DM / 64, MT / 64), dim3(256), 0, stream, XN0, (const bf16_t*)(ws + WS_WOUTA), DM, e); }
        hipLaunchKernelGGL(orc::s_rowssq, dim3(MT / 4), dim3(256), 0, stream, P); }
    if (FAST_MASK & 16) run(4, 5);
    else { { orc::ERaw3 e{XN0, K0, V0, GR, (const float*)(ws + WS_SSQ1)}; hipLaunchKernelGGL(orc::s_gemm<orc::ERaw3>, dim3(NB_IN / 64, MT / 64), dim3(256), 0, stream, Q0, (const bf16_t*)(ws + WS_WINB), DM, e); }
        hipLaunchKernelGGL(orc::s_post3, dim3((unsigned)(((size_t)MT * NB_IN + 255) / 256)), dim3(256), 0, stream, P); }
    if (FAST_MASK & 32) run(5, 6);
    else hipLaunchKernelGGL(orc::s_ret, dim3(8, 8, 32), dim3(256), 0, stream, P);
    if (FAST_MASK & 64) run(6, 7);
    else { hipLaunchKernelGGL(orc::s_norm_o1, dim3((unsigned)(((size_t)MT * BV + 255) / 256)), dim3(256), 0, stream, P);
        { orc::ERes2 e{P.out}; hipLaunchKernelGGL(orc::s_gemm<orc::ERes2>, dim3(DM / 64, MT / 64), dim3(256), 0, stream, GR, (const bf16_t*)(ws + WS_WOUTB), BV, e); } }
    run(7, 8);
#endif
}
```
